# Optimizing an MI355X kernel written in HIP

```python
import math
import jax, jax.numpy as jnp
from jax import lax
import numpy as np

D_MODEL = 1024
BATCH = 8
SEQ = 4096
DEPTH = 2

ATT_HEADS = 4
ATT_QK_DIM = 64
ATT_V_DIM = 2 * ATT_QK_DIM
ATT_WIDTH = ATT_HEADS * ATT_V_DIM
POOL_GROUPS = 4
POOL_WINDOWS = (2, 4, 8, 16)
POOL_WIDTH = 256
POOL_GDIM = POOL_WIDTH // POOL_GROUPS
CONV_WIDTH = 256
CONV_K = 3
MIX_WIDTH = ATT_WIDTH + POOL_WIDTH + CONV_WIDTH
QK_COLS = ATT_HEADS * 2 * ATT_QK_DIM
IN_COLS = 2 * QK_COLS + ATT_WIDTH + POOL_WIDTH + 3 * CONV_WIDTH
D_FF = ((8 * D_MODEL // 3 + 255) // 256) * 256
NUM_BUCKETS = 32
MAX_EXACT = NUM_BUCKETS // 2
MAX_DISTANCE = 128
Q_BLOCK = 128
EPS = 1e-6
SUBLN_EPS = 1e-5

kernel_name = "hybrid_diffattn_pool_shortconv_block"


def rmsnorm(x, g, eps=EPS):
    xf = x.astype(jnp.float32)
    y = xf * lax.rsqrt(jnp.mean(xf * xf, axis=-1, keepdims=True) + eps)
    return (y * g.astype(jnp.float32)).astype(x.dtype)


def rel_bucket(dist):
    n = jnp.maximum(dist, 0)
    nf = jnp.maximum(n, 1).astype(jnp.float32)
    large = MAX_EXACT + (jnp.log(nf / MAX_EXACT) / math.log(MAX_DISTANCE / MAX_EXACT)
                         * (NUM_BUCKETS - MAX_EXACT)).astype(jnp.int32)
    large = jnp.minimum(large, NUM_BUCKETS - 1)
    return jnp.where(n < MAX_EXACT, n, large)


def diff_attention(q1, q2, k1, k2, v, rel_bias, lam):
    b, h, s, _ = q1.shape
    nb = s // Q_BLOCK
    scale = ATT_QK_DIM ** -0.5
    kpos = jnp.arange(s)
    k1f, k2f, vf = k1.astype(jnp.float32), k2.astype(jnp.float32), v.astype(jnp.float32)

    def block(i):
        qs = i * Q_BLOCK
        qb1 = lax.dynamic_slice_in_dim(q1, qs, Q_BLOCK, axis=2).astype(jnp.float32)
        qb2 = lax.dynamic_slice_in_dim(q2, qs, Q_BLOCK, axis=2).astype(jnp.float32)
        dist = (qs + jnp.arange(Q_BLOCK))[:, None] - kpos[None, :]
        bias = jnp.transpose(rel_bias.astype(jnp.float32)[rel_bucket(dist)], (2, 0, 1))
        mask = dist >= 0
        s1 = jnp.einsum('bhqd,bhkd->bhqk', qb1, k1f) * scale + bias
        s2 = jnp.einsum('bhqd,bhkd->bhqk', qb2, k2f) * scale + bias
        p1 = jax.nn.softmax(jnp.where(mask, s1, -1e30), axis=-1)
        p2 = jax.nn.softmax(jnp.where(mask, s2, -1e30), axis=-1)
        return jnp.einsum('bhqk,bhkd->bqhd', p1 - lam * p2, vf)

    out = lax.map(block, jnp.arange(nb))
    return jnp.transpose(out, (1, 0, 2, 3, 4)).reshape(b, s, h, ATT_V_DIM)


def multiscale_pool(p, w_pool, pool_scale):
    b, s, _ = p.shape
    pf = p.astype(jnp.float32)
    csum = jnp.cumsum(pf, axis=1)
    t1 = jnp.arange(1, s + 1, dtype=jnp.float32)[None, :, None]
    groups = []
    for g, w in enumerate(POOL_WINDOWS):
        cg = csum[..., g * POOL_GDIM:(g + 1) * POOL_GDIM]
        prev = jnp.pad(cg, ((0, 0), (w, 0), (0, 0)))[:, :s]
        groups.append((cg - prev) / jnp.minimum(t1, float(w)))
    pooled = jnp.concatenate(groups, axis=-1) - pf
    mixed = jnp.einsum('bsgc,gcd->bsgd', pooled.reshape(b, s, POOL_GROUPS, POOL_GDIM),
                       w_pool.astype(jnp.float32)).reshape(b, s, POOL_WIDTH)
    return mixed * pool_scale.astype(jnp.float32)


def short_gated_conv(gb, gc, hin, conv_w):
    s = hin.shape[1]
    u = (gc * hin).astype(jnp.float32)
    up = jnp.pad(u, ((0, 0), (CONV_K - 1, 0), (0, 0)))
    wf = conv_w.astype(jnp.float32)
    y = sum(wf[k] * up[:, k:k + s] for k in range(CONV_K))
    return gb.astype(jnp.float32) * y


def setup_inputs(seed: int = 0) -> dict:
    key = jax.random.key(seed)
    ks = jax.random.split(key, 20)
    f32 = jnp.float32
    nrm = lambda k, shape, sc: jax.random.normal(k, shape, f32) * sc
    return {
        "x": nrm(ks[0], (BATCH, SEQ, D_MODEL), 1.0),
        "g_mix": 1.0 + nrm(ks[1], (DEPTH, D_MODEL), 0.01),
        "w_in": nrm(ks[2], (DEPTH, D_MODEL, IN_COLS), D_MODEL ** -0.5),
        "lambda_q1": nrm(ks[3], (DEPTH, ATT_QK_DIM), 0.1),
        "lambda_k1": nrm(ks[4], (DEPTH, ATT_QK_DIM), 0.1),
        "lambda_q2": nrm(ks[5], (DEPTH, ATT_QK_DIM), 0.1),
        "lambda_k2": nrm(ks[6], (DEPTH, ATT_QK_DIM), 0.1),
        "subln_g": 1.0 + nrm(ks[7], (DEPTH, ATT_V_DIM), 0.01),
        "rel_bias": nrm(ks[8], (NUM_BUCKETS, ATT_HEADS), 0.5),
        "w_pool": nrm(ks[9], (DEPTH, POOL_GROUPS, POOL_GDIM, POOL_GDIM), POOL_GDIM ** -0.5),
        "pool_scale": 1.0 + nrm(ks[10], (DEPTH, POOL_WIDTH), 0.1),
        "conv_w": nrm(ks[11], (DEPTH, CONV_K, CONV_WIDTH), CONV_K ** -0.5),
        "w_o": nrm(ks[12], (DEPTH, MIX_WIDTH, D_MODEL), MIX_WIDTH ** -0.5),
        "g_ffn": 1.0 + nrm(ks[13], (DEPTH, D_MODEL), 0.01),
        "w_gate": nrm(ks[14], (DEPTH, D_MODEL, D_FF), D_MODEL ** -0.5),
        "w_up": nrm(ks[15], (DEPTH, D_MODEL, D_FF), D_MODEL ** -0.5),
        "w_down": nrm(ks[16], (DEPTH, D_FF, D_MODEL), D_FF ** -0.5),
        "g_final": 1.0 + nrm(ks[17], (D_MODEL,), 0.01),
    }


def reference(x, g_mix, w_in, lambda_q1, lambda_k1, lambda_q2, lambda_k2, subln_g, rel_bias,
              w_pool, pool_scale, conv_w, w_o, g_ffn, w_gate, w_up, w_down, g_final):
    b, s, _ = x.shape
    split_pts = np.cumsum([QK_COLS, QK_COLS, ATT_WIDTH, POOL_WIDTH, CONV_WIDTH, CONV_WIDTH])
    for l in range(DEPTH):
        h = rmsnorm(x, g_mix[l])
        proj = h @ w_in[l]
        q, k, v, p, gb, gc, hin = jnp.split(proj, list(split_pts), axis=-1)
        q = q.reshape(b, s, ATT_HEADS, 2, ATT_QK_DIM)
        k = k.reshape(b, s, ATT_HEADS, 2, ATT_QK_DIM)
        q1 = jnp.transpose(q[:, :, :, 0], (0, 2, 1, 3))
        q2 = jnp.transpose(q[:, :, :, 1], (0, 2, 1, 3))
        k1 = jnp.transpose(k[:, :, :, 0], (0, 2, 1, 3))
        k2 = jnp.transpose(k[:, :, :, 1], (0, 2, 1, 3))
        vh = jnp.transpose(v.reshape(b, s, ATT_HEADS, ATT_V_DIM), (0, 2, 1, 3))
        lam_init = 0.8 - 0.6 * math.exp(-0.3 * l)
        lam = (jnp.exp(jnp.sum(lambda_q1[l].astype(jnp.float32) * lambda_k1[l].astype(jnp.float32)))
               - jnp.exp(jnp.sum(lambda_q2[l].astype(jnp.float32) * lambda_k2[l].astype(jnp.float32)))
               + lam_init)
        att = diff_attention(q1, q2, k1, k2, vh, rel_bias, lam)
        att = rmsnorm(att, subln_g[l], SUBLN_EPS) * (1.0 - lam_init)
        att = att.reshape(b, s, ATT_WIDTH)
        pool = multiscale_pool(p, w_pool[l], pool_scale[l])
        conv = short_gated_conv(gb, gc, hin, conv_w[l])
        mixed = jnp.concatenate([att, pool, conv], axis=-1).astype(x.dtype)
        x = x + (mixed @ w_o[l]).astype(x.dtype)
        h = rmsnorm(x, g_ffn[l])
        ff = (jax.nn.silu(h @ w_gate[l]) * (h @ w_up[l])) @ w_down[l]
        x = x + ff.astype(x.dtype)
    return rmsnorm(x, g_final)
```

```cpp
#include <hip/hip_runtime.h>
#include <cstdint>
#include <cstdio>
#include <cmath>

constexpr int BATCH = 8, SEQ = 4096, DM = 1024, M = BATCH * SEQ, DEPTH = 2;
constexpr int NH = 4, INC = 2560, DFF = 2816, NGU = 2 * DFF;
constexpr int C_Q = 0, C_K = 512, C_V = 1024, C_P = 1536, C_GB = 1792, C_GC = 2048, C_HIN = 2304;
constexpr float LOG2E = 1.4426950408889634f;
constexpr float QSCALE = 0.125f * LOG2E;
constexpr float RMS_EPS = 1e-6f, SUBLN_EPS = 1e-5f;
constexpr int NSSQ = 16;

__device__ __forceinline__ int rel_bucket(int n) {
    if (n < 16) return n;
    int b = 16;
    b += (n >= 19); b += (n >= 21); b += (n >= 24); b += (n >= 27); b += (n >= 31); b += (n >= 35); b += (n >= 40); b += (n >= 46);
    b += (n >= 52); b += (n >= 59); b += (n >= 67); b += (n >= 77); b += (n >= 87); b += (n >= 99); b += (n >= 113);
    return b;
}
namespace pg8 {
#define PG8_LAS __attribute__((address_space(3)))
typedef unsigned short bf16_t;
typedef short bf16x8 __attribute__((ext_vector_type(8)));
typedef float f32x4 __attribute__((ext_vector_type(4)));
typedef unsigned u32x4 __attribute__((ext_vector_type(4)));
constexpr int BM = 256, BK = 64, HALF = 128, HTB = HALF * BK * 2  , STAGE_BYTES = 8 * HTB, NXCD = 8, WGM = 8;

__host__ __device__ __forceinline__ int lds_byte(int r, int c) { const int st = (r >> 4) * 2 + (c >> 5), rr = r & 15, cc = c & 31, ob = rr * 64 + cc * 2; return st * 1024 + (ob ^ (((ob >> 9) & 1) << 5)); }
__host__ __device__ __forceinline__ void stage_rc(int b, int& R, int& C) { const int st = b / 1024, sb = b % 1024, swz = sb ^ (((sb >> 9) & 1) << 5); R = (st >> 1) * 16 + swz / 64; C = (st & 1) * 32 + (swz % 64) / 2; }
__host__ __device__ __forceinline__ int perm32(int rho) { const int n = rho >> 4, i = rho & 15; return 8 * (i >> 2) + 4 * n + (i & 3); }

struct Unit { int pm, pn; };
struct Gemm { const bf16_t* A; const bf16_t* Bt; int M, N, K; };

struct StaticOrder {
    int nM, nN, nwg, G, c;
    __host__ __device__ void init(int M, int N, int G_, int c_) { nM = M / BM; nN = N / BM; nwg = nM * nN; G = G_; c = c_; }
    __host__ __device__ bool next(int i, Unit& u) const {
        const long L = (long)i * G + c; if (L >= nwg) return false;
        int wgid = (int)L; { const int q = nwg / NXCD, r = nwg % NXCD, xcd = wgid % NXCD, off = wgid / NXCD; wgid = (xcd < r ? xcd * (q + 1) : r * (q + 1) + (xcd - r) * q) + off; }
        const int nig = WGM * nN, gid = wgid / nig, fm = gid * WGM, gsz = (nM - fm) < WGM ? (nM - fm) : WGM;
        u.pm = fm + ((wgid % nig) % gsz); u.pn = (wgid % nig) / gsz; return true;
    }
    __device__ __forceinline__ void a_ready(const Unit&) const {}
    __device__ __forceinline__ void done(const Unit&) const {}
};

typedef float f32x2 __attribute__((ext_vector_type(2)));
typedef unsigned u32x2 __attribute__((ext_vector_type(2)));
__device__ __forceinline__ unsigned cvt_pk_bf16(float lo, float hi) { typedef __bf16 bf2 __attribute__((ext_vector_type(2))); f32x2 v = {lo, hi}; bf2 b = __builtin_convertvector(v, bf2); return __builtin_bit_cast(unsigned, b); }
#ifndef WT_STORES
#define WT_STORES 1
#endif
__device__ __forceinline__ void st16(void* p, u32x4 v) {
#if WT_STORES
    asm volatile("global_store_dwordx4 %0, %1, off sc1\n\ts_nop 1" :: "v"(p), "v"(v) : "memory");
#else
    *(u32x4*)p = v;
#endif
}
__device__ __forceinline__ float row_rstd(const float* ssq, int row) {
    const f32x4 a = *(const f32x4*)(ssq + (size_t)row * 4);
    return 1.0f / sqrtf(((a[0] + a[1]) + (a[2] + a[3])) * (1.0f / 1024.0f) + 1e-6f);
}
struct EpiProj {
    static constexpr bool PERM = true, AFTER_DRAIN = false;
    bf16_t* O; bf16_t* KT; bf16_t* VT; const PG8_LAS float* rtab; int ldc; float qscale; int skip;
    __device__ __forceinline__ void operator()(const f32x4 (&acc)[2][2][4][2], const Unit& u, int ui, int wr, int wc, int fr, int fq) const {
        if (skip & 8) { _Pragma("unroll") for (int a_ = 0; a_ < 2; ++a_) _Pragma("unroll") for (int b_ = 0; b_ < 2; ++b_) _Pragma("unroll") for (int m_ = 0; m_ < 4; ++m_) _Pragma("unroll") for (int n_ = 0; n_ < 2; ++n_) asm volatile("" :: "v"(acc[a_][b_][m_][n_])); return; }
        const float cs = (u.pn < 2) ? qscale : 1.0f;
#pragma unroll
        for (int ai = 0; ai < 2; ++ai)
#pragma unroll
            for (int m = 0; m < 4; ++m) {
                const int row = u.pm * BM + ai * HALF + wr * 64 + m * 16 + fr;
                const float rs = rtab[ui * 256 + ai * HALF + wr * 64 + m * 16 + fr] * cs;
                bf16_t* rowp = O + (size_t)row * ldc + u.pn * BM + wc * 32 + 8 * fq;
                const int bb = row >> 12, tt = (row >> 6) & 63, kk = row & 63;
#pragma unroll
                for (int bj = 0; bj < 2; ++bj) { const f32x4 v0 = acc[ai][bj][m][0] * rs, v1 = acc[ai][bj][m][1] * rs;
                    u32x4 w; w.x = cvt_pk_bf16(v0[0], v0[1]); w.y = cvt_pk_bf16(v0[2], v0[3]); w.z = cvt_pk_bf16(v1[0], v1[1]); w.w = cvt_pk_bf16(v1[2], v1[3]);
                    bf16_t* dst = rowp + bj * HALF;
                    if (u.pn >= 2 && u.pn < 6) {
                        const int c0 = (u.pn & 1) * BM + bj * HALF + wc * 32 + 8 * fq;
                        const size_t img = ((size_t)(bb * 4 + (c0 >> 7)) * 64 + tt) * 8192;
                        if (u.pn < 4) dst = KT + img + (((c0 >> 6) & 1) * 8 + ((c0 & 63) >> 3)) * 512 + kk * 8;
                        else dst = VT + img + ((c0 & 127) >> 5) * 2048 + (kk >> 4) * 512 + (kk & 15) * 32 + (c0 & 31);
                    }
                    if (skip & 32) asm volatile("" :: "v"(w)); else st16(dst, w); }
            }
    }
};
struct EpiSwiGLU {
    static constexpr bool PERM = true, AFTER_DRAIN = false;
    bf16_t* O; const PG8_LAS float* rtab; int ldc; int skip;
    __device__ __forceinline__ void operator()(const f32x4 (&acc)[2][2][4][2], const Unit& u, int ui, int wr, int wc, int fr, int fq) const {
        if (skip) { _Pragma("unroll") for (int a_ = 0; a_ < 2; ++a_) _Pragma("unroll") for (int b_ = 0; b_ < 2; ++b_) _Pragma("unroll") for (int m_ = 0; m_ < 4; ++m_) _Pragma("unroll") for (int n_ = 0; n_ < 2; ++n_) asm volatile("" :: "v"(acc[a_][b_][m_][n_])); return; }
#pragma unroll
        for (int ai = 0; ai < 2; ++ai)
#pragma unroll
            for (int m = 0; m < 4; ++m) {
                const int row = u.pm * BM + ai * HALF + wr * 64 + m * 16 + fr;
                const float rs = rtab[ui * 256 + ai * HALF + wr * 64 + m * 16 + fr];
                float hv[8];
#pragma unroll
                for (int n = 0; n < 2; ++n)
#pragma unroll
                    for (int e = 0; e < 4; ++e) { const float g = acc[ai][0][m][n][e] * rs, uu = acc[ai][1][m][n][e] * rs;
                        hv[4 * n + e] = g * __builtin_amdgcn_rcpf(1.0f + __builtin_amdgcn_exp2f(-g * 1.4426950408889634f)) * uu; }
                u32x4 w; w.x = cvt_pk_bf16(hv[0], hv[1]); w.y = cvt_pk_bf16(hv[2], hv[3]); w.z = cvt_pk_bf16(hv[4], hv[5]); w.w = cvt_pk_bf16(hv[6], hv[7]);
                st16(O + (size_t)row * ldc + u.pn * HALF + wc * 32 + 8 * fq, w);
            }
    }
};
struct EpiRes {
    static constexpr bool PERM = true, AFTER_DRAIN = false;
    bf16_t* xb; float* ssq; PG8_LAS float* red;
    __device__ __forceinline__ void operator()(const f32x4 (&acc)[2][2][4][2], const Unit& u, int ui, int wr, int wc, int fr, int fq) const {
        u32x4 bs[2][4][2];
#pragma unroll
        for (int ai = 0; ai < 2; ++ai)
#pragma unroll
            for (int m = 0; m < 4; ++m) {
                const bf16_t* rowp = xb + (size_t)(u.pm * BM + ai * HALF + wr * 64 + m * 16 + fr) * 1024 + u.pn * BM + wc * 32 + 8 * fq;
#pragma unroll
                for (int bj = 0; bj < 2; ++bj) bs[ai][m][bj] = *(const u32x4*)(rowp + bj * HALF);
            }
#pragma unroll
        for (int ai = 0; ai < 2; ++ai)
#pragma unroll
            for (int m = 0; m < 4; ++m) {
                const int rl = ai * HALF + wr * 64 + m * 16 + fr, row = u.pm * BM + rl;
                bf16_t* rowp = xb + (size_t)row * 1024 + u.pn * BM + wc * 32 + 8 * fq;
                float sq = 0.f;
#pragma unroll
                for (int bj = 0; bj < 2; ++bj) {
                    const u32x4 b = bs[ai][m][bj];
                    f32x4 v0 = acc[ai][bj][m][0], v1 = acc[ai][bj][m][1];
                    v0[0] += __builtin_bit_cast(float, b.x << 16); v0[1] += __builtin_bit_cast(float, b.x & 0xffff0000u);
                    v0[2] += __builtin_bit_cast(float, b.y << 16); v0[3] += __builtin_bit_cast(float, b.y & 0xffff0000u);
                    v1[0] += __builtin_bit_cast(float, b.z << 16); v1[1] += __builtin_bit_cast(float, b.z & 0xffff0000u);
                    v1[2] += __builtin_bit_cast(float, b.w << 16); v1[3] += __builtin_bit_cast(float, b.w & 0xffff0000u);
                    sq += ((v0[0] * v0[0] + v0[1] * v0[1]) + (v0[2] * v0[2] + v0[3] * v0[3])) + ((v1[0] * v1[0] + v1[1] * v1[1]) + (v1[2] * v1[2] + v1[3] * v1[3]));
                    u32x4 w; w.x = cvt_pk_bf16(v0[0], v0[1]); w.y = cvt_pk_bf16(v0[2], v0[3]); w.z = cvt_pk_bf16(v1[0], v1[1]); w.w = cvt_pk_bf16(v1[2], v1[3]);
                    st16(rowp + bj * HALF, w);
                }
                sq += __shfl_xor(sq, 16); sq += __shfl_xor(sq, 32);
                if (fq == 0) red[rl * 4 + wc] = sq;
            }
        asm volatile("s_waitcnt lgkmcnt(0)\n\ts_barrier" ::: "memory");
        const int tid = (wr * 4 + wc) * 64 + fq * 16 + fr;
        if (tid < 256) { const f32x4 p = *(const PG8_LAS f32x4*)(red + tid * 4); ssq[(size_t)(u.pm * BM + tid) * 4 + u.pn] = (p[0] + p[1]) + (p[2] + p[3]); }
    }
};

struct EpiResFinal {
    static constexpr bool PERM = true, AFTER_DRAIN = false;
    const bf16_t* xb; float* ssq; float* out; const float* gfin; unsigned* cnt; PG8_LAS float* red;
    __device__ __forceinline__ void operator()(const f32x4 (&acc_)[2][2][4][2], const Unit& u, int ui, int wr, int wc, int fr, int fq) const {
        f32x4 (&acc)[2][2][4][2] = const_cast<f32x4 (&)[2][2][4][2]>(acc_);
        const int tid = (wr * 4 + wc) * 64 + fq * 16 + fr;
        u32x4 bs[2][4][2];
#pragma unroll
        for (int ai = 0; ai < 2; ++ai)
#pragma unroll
            for (int m = 0; m < 4; ++m) {
                const bf16_t* rowp = xb + (size_t)(u.pm * BM + ai * HALF + wr * 64 + m * 16 + fr) * 1024 + u.pn * BM + wc * 32 + 8 * fq;
#pragma unroll
                for (int bj = 0; bj < 2; ++bj) bs[ai][m][bj] = *(const u32x4*)(rowp + bj * HALF);
            }
#pragma unroll
        for (int ai = 0; ai < 2; ++ai)
#pragma unroll
            for (int m = 0; m < 4; ++m) {
                const int rl = ai * HALF + wr * 64 + m * 16 + fr, row = u.pm * BM + rl;
                float sq = 0.f;
#pragma unroll
                for (int bj = 0; bj < 2; ++bj) {
                    const u32x4 b = bs[ai][m][bj];
                    f32x4 v0 = acc[ai][bj][m][0], v1 = acc[ai][bj][m][1];
                    v0[0] += __builtin_bit_cast(float, b.x << 16); v0[1] += __builtin_bit_cast(float, b.x & 0xffff0000u);
                    v0[2] += __builtin_bit_cast(float, b.y << 16); v0[3] += __builtin_bit_cast(float, b.y & 0xffff0000u);
                    v1[0] += __builtin_bit_cast(float, b.z << 16); v1[1] += __builtin_bit_cast(float, b.z & 0xffff0000u);
                    v1[2] += __builtin_bit_cast(float, b.w << 16); v1[3] += __builtin_bit_cast(float, b.w & 0xffff0000u);
                    sq += ((v0[0] * v0[0] + v0[1] * v0[1]) + (v0[2] * v0[2] + v0[3] * v0[3])) + ((v1[0] * v1[0] + v1[1] * v1[1]) + (v1[2] * v1[2] + v1[3] * v1[3]));
                    acc[ai][bj][m][0] = v0; acc[ai][bj][m][1] = v1;
                }
                sq += __shfl_xor(sq, 16); sq += __shfl_xor(sq, 32);
                if (fq == 0) red[rl * 4 + wc] = sq;
            }
        asm volatile("s_waitcnt lgkmcnt(0)\n\ts_barrier" ::: "memory");
        if (tid < 256) { const f32x4 p = *(const PG8_LAS f32x4*)(red + tid * 4);
            __hip_atomic_store(ssq + (size_t)(u.pm * BM + tid) * 4 + u.pn, (p[0] + p[1]) + (p[2] + p[3]), __ATOMIC_RELAXED, __HIP_MEMORY_SCOPE_AGENT); }
        asm volatile("s_waitcnt vmcnt(0)\n\ts_barrier" ::: "memory");
        unsigned* c = cnt + 64 * u.pm;
        if (tid == 0) __hip_atomic_fetch_add(c, 1u, __ATOMIC_RELAXED, __HIP_MEMORY_SCOPE_AGENT);
        if (tid < 64) {
            unsigned sp = 0u;
            while ((unsigned)__builtin_amdgcn_readfirstlane(__hip_atomic_load(c, __ATOMIC_RELAXED, __HIP_MEMORY_SCOPE_AGENT)) < 4u) { __builtin_amdgcn_s_sleep(2); if (++sp > (1u << 22)) break; }
            __builtin_amdgcn_fence(__ATOMIC_ACQUIRE, "agent");
        }
        asm volatile("s_waitcnt vmcnt(0) lgkmcnt(0)\n\ts_barrier" ::: "memory");
        PG8_LAS float* rs = red + 1024;
        if (tid < 256) { const float* sp4 = ssq + (size_t)(u.pm * BM + tid) * 4; float s = 0.f;
#pragma unroll
            for (int t = 0; t < 4; ++t) s += __hip_atomic_load(sp4 + t, __ATOMIC_RELAXED, __HIP_MEMORY_SCOPE_AGENT);
            rs[tid] = 1.0f / sqrtf(s * (1.0f / 1024.0f) + 1e-6f); }
        asm volatile("s_waitcnt vmcnt(0) lgkmcnt(0)\n\ts_barrier" ::: "memory");
        f32x4 g[2][2];
#pragma unroll
        for (int bj = 0; bj < 2; ++bj)
#pragma unroll
            for (int n = 0; n < 2; ++n) g[bj][n] = *(const f32x4*)(gfin + u.pn * BM + bj * HALF + wc * 32 + 8 * fq + 4 * n);
#pragma unroll
        for (int ai = 0; ai < 2; ++ai)
#pragma unroll
            for (int m = 0; m < 4; ++m) {
                const int rl = ai * HALF + wr * 64 + m * 16 + fr, row = u.pm * BM + rl;
                const float r = rs[rl];
                float* op = out + (size_t)row * 1024 + u.pn * BM + wc * 32 + 8 * fq;
#pragma unroll
                for (int bj = 0; bj < 2; ++bj)
#pragma unroll
                    for (int n = 0; n < 2; ++n) *(f32x4*)(op + bj * HALF + 4 * n) = acc[ai][bj][m][n] * r * g[bj][n];
            }
    }
};
template <class Epi, class Sched, bool ALIGN_EPI = false, bool SP2 = false>
__device__ __forceinline__ void gemm_phase(PG8_LAS unsigned char* lds, const Gemm g, const Sched& S, const Epi& E) {
    int tid_ = threadIdx.x; asm volatile("" : "+v"(tid_));
    const int tid = tid_, wid = __builtin_amdgcn_readfirstlane(tid >> 6), lane = tid & 63, wr = wid >> 2, wc = wid & 3, fr = lane & 15, fq = lane >> 4;
    const int K = g.K, nt = K / BK;
    unsigned voffA[2], voffB[2];
#pragma unroll
    for (int i = 0; i < 2; ++i) { int R, C; stage_rc(tid * 16 + i * 8192, R, C); const int Rb = Epi::PERM ? ((R & ~31) + perm32(R & 31)) : R;
        voffA[i] = (unsigned)(R * K + C) * 2u; voffB[i] = (unsigned)(Rb * K + C) * 2u; }
    const size_t kstep = (size_t)(BK * 2);
    const size_t hstep = (size_t)HALF * K * 2;
    const size_t tstep = 2 * hstep;
    const unsigned ldsw = (unsigned)wid * 1024u;
    const int aoff = lds_byte(wr * 64 + fr, fq * 8), boff = lds_byte(wc * 32 + fr, fq * 8);
#define PG8_SA(b, h) (((b) * 2 + (h)) * HTB)
#define PG8_SB(b, h) ((4 + (b) * 2 + (h)) * HTB)
#define PG8_STAGE(bufoff, gbase, voff) do { _Pragma("unroll") for (int _i = 0; _i < 2; ++_i) \
        __builtin_amdgcn_global_load_lds((const unsigned*)((const char*)(gbase) + (voff)[_i]), (PG8_LAS unsigned*)(lds + (bufoff) + ldsw + _i * 8192), 16, 0, 0); } while (0)
#define PG8_LDA(dst, b, h) do { _Pragma("unroll") for (int m = 0; m < 4; ++m) _Pragma("unroll") for (int k = 0; k < 2; ++k) dst[m][k] = *(const PG8_LAS bf16x8*)(lds + PG8_SA(b, h) + aoff + m * 2048 + k * 1024); } while (0)
#define PG8_LDB(dst, b, h) do { _Pragma("unroll") for (int n = 0; n < 2; ++n) _Pragma("unroll") for (int k = 0; k < 2; ++k) dst[n][k] = *(const PG8_LAS bf16x8*)(lds + PG8_SB(b, h) + boff + n * 2048 + k * 1024); } while (0)
#define PG8_MMA(ai, bj, At, Bt) do { __builtin_amdgcn_s_setprio(1); _Pragma("unroll") for (int m = 0; m < 4; ++m) _Pragma("unroll") for (int n = 0; n < 2; ++n) _Pragma("unroll") for (int k = 0; k < 2; ++k) \
        acc[ai][bj][m][n] = __builtin_amdgcn_mfma_f32_16x16x32_bf16(Bt[n][k], At[m][k], acc[ai][bj][m][n], 0, 0, 0); __builtin_amdgcn_s_setprio(0); } while (0)
#define PG8_WAIT_V(n) asm volatile("s_waitcnt vmcnt(" #n ")" ::: "memory")
#define PG8_WAIT_L(n) asm volatile("s_waitcnt lgkmcnt(" #n ")" ::: "memory")
#define PG8_BAR __builtin_amdgcn_s_barrier()
#define PG8_SCHED __builtin_amdgcn_sched_barrier(0)
    Unit cur, nxt; int ui = 0;
    if (!S.next(0, cur)) return;
    f32x4 acc[2][2][4][2];
#pragma unroll
    for (int a = 0; a < 2; ++a)
#pragma unroll
        for (int b = 0; b < 2; ++b)
#pragma unroll
            for (int m = 0; m < 4; ++m)
#pragma unroll
                for (int n = 0; n < 2; ++n) acc[a][b][m][n] = (f32x4){0.f, 0.f, 0.f, 0.f};
    bf16x8 At[4][2], B0[2][2], B1[2][2];
    const char* cA = (const char*)g.A + (size_t)cur.pm * tstep; const char* cB = (const char*)g.Bt + (size_t)cur.pn * tstep;
    S.a_ready(cur);
    if constexpr (SP2) {
        PG8_STAGE(PG8_SB(0, 0), cB, voffB); PG8_STAGE(PG8_SB(0, 1), cB + hstep, voffB); PG8_STAGE(PG8_SA(0, 0), cA, voffA); PG8_STAGE(PG8_SA(0, 1), cA + hstep, voffA);
        if (wr == 1) PG8_BAR;
        PG8_WAIT_V(2); PG8_BAR;
        PG8_STAGE(PG8_SB(1, 0), cB + kstep, voffB); PG8_STAGE(PG8_SA(1, 0), cA + kstep, voffA); PG8_STAGE(PG8_SB(1, 1), cB + hstep + kstep, voffB);
        PG8_WAIT_V(6); PG8_BAR;
    } else {
        PG8_STAGE(PG8_SB(0, 0), cB, voffB); PG8_STAGE(PG8_SA(0, 0), cA, voffA); PG8_STAGE(PG8_SB(0, 1), cB + hstep, voffB); PG8_STAGE(PG8_SA(0, 1), cA + hstep, voffA);
        if (wr == 1) PG8_BAR;
        PG8_WAIT_V(4); PG8_BAR;
        PG8_STAGE(PG8_SB(1, 0), cB + kstep, voffB); PG8_STAGE(PG8_SA(1, 0), cA + kstep, voffA); PG8_STAGE(PG8_SB(1, 1), cB + hstep + kstep, voffB);
        PG8_WAIT_V(6); PG8_BAR;
    }
    for (;;) {
        const bool has_next = S.next(ui + 1, nxt);
        const char* nA = has_next ? (const char*)g.A + (size_t)nxt.pm * tstep : cA; const char* nB = has_next ? (const char*)g.Bt + (size_t)nxt.pn * tstep : cB;
        for (int t = 0; t < nt; t += 2) {
            const bool last = (t == nt - 2);
            const char* a1 = cA + (size_t)(t + 1) * kstep;
            const char* a2 = last ? nA : cA + (size_t)(t + 2) * kstep; const char* b2 = last ? nB : cB + (size_t)(t + 2) * kstep;
            const char* a3 = a2 + kstep; const char* b3 = b2 + kstep;
            if (last && has_next) S.a_ready(nxt);
            if constexpr (SP2) {
            PG8_LDB(B0, 0, 0); PG8_LDB(B1, 0, 1); PG8_SCHED; PG8_LDA(At, 0, 0); PG8_STAGE(PG8_SA(1, 1), a1 + hstep, voffA);
            PG8_WAIT_V(8); PG8_WAIT_L(0); PG8_BAR; PG8_MMA(0, 0, At, B0); PG8_MMA(0, 1, At, B1); PG8_BAR; PG8_SCHED;
            PG8_LDA(At, 0, 1); PG8_STAGE(PG8_SB(0, 0), b2, voffB); PG8_STAGE(PG8_SB(0, 1), b2 + hstep, voffB); PG8_STAGE(PG8_SA(0, 0), a2, voffA);
            PG8_WAIT_V(8); PG8_WAIT_L(0); PG8_BAR; PG8_MMA(1, 0, At, B0); PG8_MMA(1, 1, At, B1); PG8_BAR; PG8_SCHED;
            PG8_LDB(B0, 1, 0); PG8_LDB(B1, 1, 1); PG8_SCHED; PG8_LDA(At, 1, 0); PG8_STAGE(PG8_SA(0, 1), a2 + hstep, voffA);
            PG8_WAIT_V(8); PG8_WAIT_L(0); PG8_BAR; PG8_MMA(0, 0, At, B0); PG8_MMA(0, 1, At, B1); PG8_BAR; PG8_SCHED;
            PG8_LDA(At, 1, 1); PG8_STAGE(PG8_SB(1, 0), b3, voffB); PG8_STAGE(PG8_SB(1, 1), b3 + hstep, voffB); PG8_STAGE(PG8_SA(1, 0), a3, voffA);
            PG8_WAIT_V(8); PG8_WAIT_L(0); PG8_BAR; PG8_MMA(1, 0, At, B0); PG8_MMA(1, 1, At, B1); PG8_BAR; PG8_SCHED;
            } else {
            PG8_LDB(B0, 0, 0); PG8_SCHED; PG8_LDA(At, 0, 0); PG8_STAGE(PG8_SA(1, 1), a1 + hstep, voffA);
            PG8_WAIT_L(8); PG8_BAR; PG8_WAIT_L(0); PG8_MMA(0, 0, At, B0); PG8_BAR; PG8_SCHED;
            PG8_LDB(B1, 0, 1); PG8_STAGE(PG8_SB(0, 0), b2, voffB);
            PG8_BAR; PG8_WAIT_L(0); PG8_MMA(0, 1, At, B1); PG8_BAR;
            PG8_LDA(At, 0, 1); PG8_STAGE(PG8_SA(0, 0), a2, voffA);
            PG8_BAR; PG8_WAIT_L(0); PG8_MMA(1, 0, At, B0); PG8_BAR; PG8_SCHED;
            PG8_STAGE(PG8_SB(0, 1), b2 + hstep, voffB);
            PG8_WAIT_V(6); PG8_BAR; PG8_MMA(1, 1, At, B1); PG8_BAR;
            PG8_LDB(B0, 1, 0); PG8_SCHED; PG8_LDA(At, 1, 0); PG8_STAGE(PG8_SA(0, 1), a2 + hstep, voffA);
            PG8_WAIT_L(8); PG8_BAR; PG8_WAIT_L(0); PG8_MMA(0, 0, At, B0); PG8_BAR; PG8_SCHED;
            PG8_LDB(B1, 1, 1); PG8_STAGE(PG8_SB(1, 0), b3, voffB);
            PG8_BAR; PG8_WAIT_L(0); PG8_MMA(0, 1, At, B1); PG8_BAR;
            PG8_LDA(At, 1, 1); PG8_STAGE(PG8_SA(1, 0), a3, voffA);
            PG8_BAR; PG8_WAIT_L(0); PG8_MMA(1, 0, At, B0); PG8_BAR; PG8_SCHED;
            PG8_STAGE(PG8_SB(1, 1), b3 + hstep, voffB);
            PG8_WAIT_V(6); PG8_BAR; PG8_MMA(1, 1, At, B1); PG8_BAR;
            }
        }
        if constexpr (ALIGN_EPI) { if (wr == 0) PG8_BAR; }
        if constexpr (!Epi::AFTER_DRAIN) { E(acc, cur, ui, wr, wc, fr, fq); S.done(cur); }
        if (!has_next) break;
#pragma unroll
        for (int a = 0; a < 2; ++a)
#pragma unroll
            for (int b = 0; b < 2; ++b)
#pragma unroll
                for (int m = 0; m < 4; ++m)
#pragma unroll
                    for (int n = 0; n < 2; ++n) acc[a][b][m][n] = (f32x4){0.f, 0.f, 0.f, 0.f};
        cur = nxt; cA = nA; cB = nB; ++ui;
        if constexpr (ALIGN_EPI) { if (wr == 1) PG8_BAR; }
    }
    PG8_WAIT_V(0);
    if constexpr (!ALIGN_EPI) { if (wr == 0) PG8_BAR; }
    PG8_BAR;
    if constexpr (Epi::AFTER_DRAIN) { E.fused(acc, cur, wr, wc, fr, fq, lds, wid, lane); S.done(cur); }
#undef PG8_SA
#undef PG8_SB
#undef PG8_STAGE
#undef PG8_LDA
#undef PG8_LDB
#undef PG8_MMA
#undef PG8_WAIT_V
#undef PG8_WAIT_L
#undef PG8_BAR
#undef PG8_SCHED
}
}

#ifndef PG8_SP2
#define PG8_SP2 true
#endif
#ifndef PG8_ALIGN
#define PG8_ALIGN true
#endif
namespace att3 {
using bf16x8 = __attribute__((ext_vector_type(8))) short;
using s16x4 = __attribute__((ext_vector_type(4))) short;
using f32x16 = __attribute__((ext_vector_type(16))) float;
using u32x4 = __attribute__((ext_vector_type(4))) unsigned;
typedef __attribute__((address_space(3))) char* lds_ptr;
typedef __attribute__((address_space(3))) const char* lds_cptr;
typedef short v4i16_t __attribute__((ext_vector_type(4)));
typedef __attribute__((address_space(3))) float* lds_fptr;
constexpr int KVBLK = 64, QROWS = 128, NSLOT = 3, SLOTB = 16384;
constexpr int LDS_K = 0, LDS_V = NSLOT * SLOTB, LDS_WS = 131072 + 1024, LDS_BT = LDS_WS + 8 * 256, LDS_CMB = 65536;
#define SBAR() __builtin_amdgcn_sched_barrier(0)
#define PIN(x) asm volatile("" : "+v"(x))
#define WAIT_BAR(N) asm volatile("s_waitcnt vmcnt(" #N ") lgkmcnt(0)\n\ts_barrier" ::: "memory")
#define MFMA(a, b, c) __builtin_amdgcn_mfma_f32_32x32x16_bf16(a, b, c, 0, 0, 0)
#define MX3(a, b, c) __builtin_fmaxf(__builtin_fmaxf((a), (b)), (c))
#define EX(v) __builtin_amdgcn_exp2f(v)
__device__ __forceinline__ int crow(int r, int hi) { return (r & 3) + 8 * (r >> 2) + 4 * hi; }
__device__ __forceinline__ void glds16(const void* gsrc, unsigned lds_dst) { unsigned keep;
    asm volatile("s_mov_b32 %0, m0\n\ts_mov_b32 m0, %2\n\ts_nop 0\n\tglobal_load_lds_dwordx4 %1, off\n\ts_mov_b32 m0, %0" : "=&s"(keep) : "v"(gsrc), "s"(lds_dst) : "memory"); }
__device__ __forceinline__ s16x4 vtr(lds_cptr p) { return __builtin_bit_cast(s16x4, __builtin_amdgcn_ds_read_tr16_b64_v4i16((__attribute__((address_space(3))) v4i16_t*)p)); }
__device__ __forceinline__ unsigned cvtpk(float lo, float hi) { typedef float f2 __attribute__((ext_vector_type(2))); typedef __bf16 b2 __attribute__((ext_vector_type(2))); f2 v = {lo, hi}; b2 b = __builtin_convertvector(v, b2); return __builtin_bit_cast(unsigned, b); }
__device__ __forceinline__ void kload2(bf16x8* kf, lds_cptr kp, int j) { kf[2 * j] = *(const __attribute__((address_space(3))) bf16x8*)(kp + j * 2048); kf[2 * j + 1] = *(const __attribute__((address_space(3))) bf16x8*)(kp + j * 2048 + 512); }
__device__ __forceinline__ float half_sum(float m) { auto rr = __builtin_amdgcn_permlane32_swap(__float_as_uint(m), __float_as_uint(m), false, false); return __uint_as_float(rr[0]) + __uint_as_float(rr[1]); }

struct Params { const unsigned short* proj; const unsigned short* kt; const unsigned short* vt; unsigned short* mix; const float* rel_bias; const float* subln_g; float lam, lam_init; };

__device__ __forceinline__ void band(f32x16& p0, f32x16& p1, int kv0, int qpos, int hi, lds_fptr btab) {
    const int db = qpos - kv0 - 4 * hi;
    const lds_fptr bp = btab + (db + 128 - 59);
    f32x16 bb;
#pragma unroll
    for (int r = 0; r < 16; ++r) bb[r] = bp[59 - ((r & 3) + 8 * (r >> 2))];
    PIN(bb);
#pragma unroll
    for (int r = 0; r < 16; ++r) p0[r] = (db - ((r & 3) + 8 * (r >> 2))) < 0 ? -INFINITY : p0[r] + bb[r];
    PIN(p0);
#pragma unroll
    for (int r = 0; r < 16; ++r) bb[r] = bp[59 - ((r & 3) + 8 * (r >> 2)) - 32];
    PIN(bb);
#pragma unroll
    for (int r = 0; r < 16; ++r) p1[r] = (db - ((r & 3) + 8 * (r >> 2))) < 32 ? -INFINITY : p1[r] + bb[r];
}

template <int THRL>
__device__ __forceinline__ void attn_unit(int b, int h, int qb, bool pre, bool newtab, int nb, int nh, int nqb, const Params& P, lds_ptr lds) {
    int tid_ = threadIdx.x; asm volatile("" : "+v"(tid_));
    const int tid = tid_, lane = tid & 63, r32 = lane & 31, hi = lane >> 5; const int wid = __builtin_amdgcn_readfirstlane(tid >> 6);
    const int map = wid >> 2, rg = wid & 3;
    const size_t rowbase = (size_t)b * SEQ; const int q0 = qb * QROWS, qrow0 = q0 + rg * 32, qpos = qrow0 + r32;
    const int NT = (q0 + QROWS) / KVBLK;
    const unsigned lds0 = (unsigned)(uintptr_t)lds;
    const lds_fptr wsf = (lds_fptr)(lds + LDS_WS) + wid * 64;
    const lds_fptr btab = (lds_fptr)(lds + LDS_BT);
    if (newtab && tid < 384) { const int d = tid - 128; btab[tid] = d < 0 ? -INFINITY : (d < 128 ? (P.rel_bias[rel_bucket(d) * NH + h] - P.rel_bias[31 * NH + h]) * LOG2E : 0.f); }
    const unsigned short* ksrc = P.kt + (size_t)(b * NH + h) * 64 * 8192 + wid * 512 + lane * 8;
    const unsigned short* vsrc = P.vt + (size_t)(b * NH + h) * 64 * 8192 + wid * 512 + lane * 8;
    const unsigned kdst = lds0 + LDS_K + wid * 1024, vdst = lds0 + LDS_V + wid * 1024;
#define DMA_K(t, slot) do { const unsigned short* s_ = ksrc + (size_t)(t) * 8192; glds16(s_, (unsigned)__builtin_amdgcn_readfirstlane(kdst + (slot))); glds16(s_ + 4096, (unsigned)__builtin_amdgcn_readfirstlane(kdst + 8192 + (slot))); } while (0)
#define DMA_V(t, slot) do { const unsigned short* s_ = vsrc + (size_t)(t) * 8192; glds16(s_, (unsigned)__builtin_amdgcn_readfirstlane(vdst + (slot))); glds16(s_ + 4096, (unsigned)__builtin_amdgcn_readfirstlane(vdst + 8192 + (slot))); } while (0)
    const lds_cptr shm3 = (lds_cptr)lds;
    const lds_cptr kp0 = shm3 + LDS_K + map * 8192 + hi * 1024 + r32 * 16;
    const lds_cptr vp0 = shm3 + LDS_V + ((lane >> 4) & 1) * 32 + (lane & 3) * 8 + (4 * hi + ((lane & 15) >> 2)) * 64;
    if (!pre) { DMA_K(0, 0); DMA_V(0, 0); DMA_K(1, SLOTB); if (NT > 2) DMA_K(2, 2 * SLOTB); }
    bf16x8 qr[4];
    { const unsigned short* Qw = P.proj + (rowbase + qpos) * INC + C_Q + h * 128 + map * 64 + hi * 8;
#pragma unroll
      for (int d0 = 0; d0 < 4; ++d0) qr[d0] = *reinterpret_cast<const bf16x8*>(Qw + d0 * 16); }
    float mhat = 0.f, l_reg = 0.f;
    f32x16 o[4];
#pragma unroll
    for (int d = 0; d < 4; ++d)
#pragma unroll
        for (int r = 0; r < 16; ++r) o[d][r] = 0.f;
    f32x16 negm;
#pragma unroll
    for (int r = 0; r < 16; ++r) negm[r] = 0.f;
    asm volatile("" : "+v"(negm));
    bool resc = false;
#define BAND(P0, P1, t) do { if ((t) >= NT - 4) band(P0, P1, (t) * KVBLK, qpos, hi, btab); } while (0)
#define RESC() do { if (resc) { asm volatile("s_waitcnt lgkmcnt(0)" ::: "memory"); \
      _Pragma("unroll") for (int r = 0; r < 16; ++r) { const float f_ = wsf[crow(r, hi)]; _Pragma("unroll") for (int d_ = 0; d_ < 4; ++d_) o[d_][r] *= f_; } } } while (0)
    f32x16 pA0, pA1, pB0, pB1;
    bf16x8 kf[8];
    int sl_prev = 0, sl_cur = 0, sl_next = SLOTB;
#define ROT() do { sl_prev = sl_cur; sl_cur = sl_next; sl_next = (sl_next == (NSLOT - 1) * SLOTB) ? 0 : sl_next + SLOTB; } while (0)
    WAIT_BAR(0);
    {
        pA0 = negm; pA1 = negm;
#pragma unroll
        for (int j = 0; j < 4; ++j) kload2(kf, kp0, j);
        PIN(kf[0]); PIN(kf[2]); PIN(kf[4]); PIN(kf[6]);
#pragma unroll
        for (int d0 = 0; d0 < 4; ++d0) { pA0 = MFMA(kf[2 * d0], qr[d0], pA0); pA1 = MFMA(kf[2 * d0 + 1], qr[d0], pA1); }
        BAND(pA0, pA1, 0);
        float rm = MX3(pA0[0], pA0[1], pA1[0]);
#pragma unroll
        for (int r = 1; r < 16; ++r) rm = MX3(rm, pA0[r], pA1[r]);
        { auto rr = __builtin_amdgcn_permlane32_swap(__float_as_uint(rm), __float_as_uint(rm), false, false); rm = __builtin_fmaxf(__uint_as_float(rr[0]), __uint_as_float(rr[1])); }
        mhat = rm;
#pragma unroll
        for (int r = 0; r < 16; ++r) { pA0[r] = EX(pA0[r] - rm); pA1[r] = EX(pA1[r] - rm); negm[r] = -mhat; }
        asm volatile("" : "+v"(negm));
    }
    WAIT_BAR(0);
    if (3 < NT) DMA_K(3, 0);
    DMA_V(1, SLOTB);
    ROT();
#pragma unroll
    for (int j = 0; j < 4; ++j) kload2(kf, kp0 + sl_cur, j);
    if (3 < NT) WAIT_BAR(4); else if (2 < NT) WAIT_BAR(2); else WAIT_BAR(0);
    u32x4 pw0, pw1, pw2, pw3;
    s16x4 va0, va1, vb0, vb1, vc0, vc1, vd0, vd1, ve0, ve1, vf0, vf1;
#define PKW(P_, B_) cvtpk(P_[B_], P_[(B_) + 1])
#define VFRAG(lo_, hi_) (bf16x8){lo_[0], lo_[1], lo_[2], lo_[3], hi_[0], hi_[1], hi_[2], hi_[3]}
#define VRD(lo_, hi_, i_) do { lo_ = vtr(vp_ + (((i_) & 3) * 4096 + ((i_) >> 2) * 1024)); hi_ = vtr(vp_ + (((i_) & 3) * 4096 + ((i_) >> 2) * 1024 + 512)); } while (0)
#define GAPA(MF, A0, A1, A2, A3, W0, W1, PW) do { MF; sacc += A0; sacc += A1; sacc += A2; sacc += A3; PIN(sacc); W0; W1; PIN(PW); SBAR(); } while (0)
#define KRD(G, j) do { if (G) { kload2(kf, kp0 + sl_next, j); } } while (0)
#define GAPB(i_, PW_, lo_, hi_, X_, B_, RD) do { RD; o[(i_) & 3] = MFMA(__builtin_bit_cast(bf16x8, PW_), VFRAG(lo_, hi_), o[(i_) & 3]); X_[B_] = EX(X_[B_]); X_[(B_) + 1] = EX(X_[(B_) + 1]); PIN(X_); SBAR(); } while (0)
#define STEP(C0, C1, P0, P1, t, GK, GV, GL) do { SBAR(); \
    const lds_cptr vp_ = vp0 + sl_prev; \
    float sacc = (P0[0] + P0[1]); \
    GAPA(C0 = MFMA(kf[0], qr[0], negm), P0[2], P0[3], P0[4], P0[5],     pw0[0] = PKW(P0, 0),  pw0[1] = PKW(P0, 2),  pw0); \
    GAPA(C1 = MFMA(kf[1], qr[0], negm), P0[6], P0[7], P0[8], P0[9],     pw0[2] = PKW(P0, 4),  pw0[3] = PKW(P0, 6),  pw0); \
    GAPA(C0 = MFMA(kf[2], qr[1], C0),   P0[10], P0[11], P0[12], P0[13], pw1[0] = PKW(P0, 8),  pw1[1] = PKW(P0, 10), pw1); \
    GAPA(C1 = MFMA(kf[3], qr[1], C1),   P0[14], P0[15], P1[0], P1[1],   pw1[2] = PKW(P0, 12), pw1[3] = PKW(P0, 14), pw1); \
    VRD(va0, va1, 0); SBAR(); \
    GAPA(C0 = MFMA(kf[4], qr[2], C0),   P1[2], P1[3], P1[4], P1[5],     pw2[0] = PKW(P1, 0),  pw2[1] = PKW(P1, 2),  pw2); \
    VRD(vb0, vb1, 1); SBAR(); \
    GAPA(C1 = MFMA(kf[5], qr[2], C1),   P1[6], P1[7], P1[8], P1[9],     pw2[2] = PKW(P1, 4),  pw2[3] = PKW(P1, 6),  pw2); \
    VRD(vc0, vc1, 2); SBAR(); \
    GAPA(C0 = MFMA(kf[6], qr[3], C0),   P1[10], P1[11], P1[12], P1[13], pw3[0] = PKW(P1, 8),  pw3[1] = PKW(P1, 10), pw3); \
    VRD(vd0, vd1, 3); SBAR(); \
    GAPA(C1 = MFMA(kf[7], qr[3], C1),   P1[14], P1[15], 0.f, 0.f,       pw3[2] = PKW(P1, 12), pw3[3] = PKW(P1, 14), pw3); \
    l_reg += sacc; \
    if (GK) { DMA_K((t) + 3, sl_cur); } if (GV) { DMA_V((t) + 1, sl_next); } \
    BAND(C0, C1, t); \
    { float a = MX3(C0[0], C0[1], C1[0]), b_ = MX3(C0[2], C0[3], C1[1]); a = MX3(a, C1[2], C1[3]); \
      _Pragma("unroll") for (int r = 4; r < 16; r += 4) { a = MX3(a, C0[r], C0[r + 1]); b_ = MX3(b_, C0[r + 2], C0[r + 3]); a = MX3(a, C1[r], C1[r + 1]); b_ = MX3(b_, C1[r + 2], C1[r + 3]); } \
      float rm = __builtin_fmaxf(a, b_); { auto rr = __builtin_amdgcn_permlane32_swap(__float_as_uint(rm), __float_as_uint(rm), false, false); rm = __builtin_fmaxf(__uint_as_float(rr[0]), __uint_as_float(rr[1])); } \
      resc = false; \
      if (__builtin_expect(__any(rm > (float)THRL), 0)) { const float dl = __builtin_fmaxf(rm, 0.f); mhat += dl; \
        _Pragma("unroll") for (int r = 0; r < 16; ++r) { C0[r] -= dl; C1[r] -= dl; } \
        _Pragma("unroll") for (int r = 0; r < 16; ++r) negm[r] = -mhat; asm volatile("" : "+v"(negm)); \
        const float f = __builtin_amdgcn_exp2f(-dl); l_reg *= f; if (hi == 0) wsf[r32] = f; resc = true; } } \
    SBAR(); \
    GAPB(0, pw0, va0, va1, C0, 0, VRD(ve0, ve1, 4)); \
    GAPB(1, pw0, vb0, vb1, C0, 2, VRD(vf0, vf1, 5)); \
    GAPB(2, pw0, vc0, vc1, C0, 4, VRD(va0, va1, 6); KRD(GL, 0)); \
    GAPB(3, pw0, vd0, vd1, C0, 6, VRD(vb0, vb1, 7)); \
    GAPB(4, pw1, ve0, ve1, C0, 8, VRD(vc0, vc1, 8); KRD(GL, 1)); \
    GAPB(5, pw1, vf0, vf1, C0, 10, VRD(vd0, vd1, 9)); \
    GAPB(6, pw1, va0, va1, C0, 12, VRD(ve0, ve1, 10); KRD(GL, 2)); \
    GAPB(7, pw1, vb0, vb1, C0, 14, VRD(vf0, vf1, 11)); \
    GAPB(8, pw2, vc0, vc1, C1, 0, VRD(va0, va1, 12); KRD(GL, 3)); \
    GAPB(9, pw2, vd0, vd1, C1, 2, VRD(vb0, vb1, 13)); \
    GAPB(10, pw2, ve0, ve1, C1, 4, VRD(vc0, vc1, 14)); \
    GAPB(11, pw2, vf0, vf1, C1, 6, VRD(vd0, vd1, 15)); \
    GAPB(12, pw3, va0, va1, C1, 8, (void)0); \
    GAPB(13, pw3, vb0, vb1, C1, 10, (void)0); \
    GAPB(14, pw3, vc0, vc1, C1, 12, (void)0); \
    GAPB(15, pw3, vd0, vd1, C1, 14, (void)0); \
    } while (0)
#define ENDW(tt) do { if ((tt) + 3 < NT) { WAIT_BAR(4); } else if ((tt) + 2 < NT) { WAIT_BAR(2); } else { WAIT_BAR(0); } } while (0)
    int t = 1;
    for (; t + 5 < NT; t += 2) {
        STEP(pB0, pB1, pA0, pA1, t, true, true, true);         WAIT_BAR(4); RESC(); ROT();
        STEP(pA0, pA1, pB0, pB1, t + 1, true, true, true);     WAIT_BAR(4); RESC(); ROT();
    }
    for (; t + 1 < NT; t += 2) {
        STEP(pB0, pB1, pA0, pA1, t, (t + 3 < NT), (t + 1 < NT), (t + 1 < NT));         ENDW(t);     RESC(); ROT();
        STEP(pA0, pA1, pB0, pB1, t + 1, (t + 4 < NT), (t + 2 < NT), (t + 2 < NT));     ENDW(t + 1); RESC(); ROT();
    }
    STEP(pB0, pB1, pA0, pA1, NT - 1, false, false, false); RESC();
    {
        float sacc = 0.f;
#pragma unroll
        for (int r = 0; r < 16; ++r) sacc += pB0[r] + pB1[r];
        l_reg += sacc;
        pw0 = (u32x4){PKW(pB0, 0), PKW(pB0, 2), PKW(pB0, 4), PKW(pB0, 6)}; pw1 = (u32x4){PKW(pB0, 8), PKW(pB0, 10), PKW(pB0, 12), PKW(pB0, 14)};
        pw2 = (u32x4){PKW(pB1, 0), PKW(pB1, 2), PKW(pB1, 4), PKW(pB1, 6)}; pw3 = (u32x4){PKW(pB1, 8), PKW(pB1, 10), PKW(pB1, 12), PKW(pB1, 14)};
        const lds_cptr vp_ = vp0 + sl_cur;
        s16x4 da0, da1, db0, db1, dc0, dc1, dd0, dd1;
        VRD(da0, da1, 0); VRD(db0, db1, 1); VRD(dc0, dc1, 2); VRD(dd0, dd1, 3); SBAR();
#define DGAP(i_, PW_, lo_, hi_, RD) do { o[(i_) & 3] = MFMA(__builtin_bit_cast(bf16x8, PW_), VFRAG(lo_, hi_), o[(i_) & 3]); RD; SBAR(); } while (0)
        DGAP(0, pw0, da0, da1, VRD(da0, da1, 4));   DGAP(1, pw0, db0, db1, VRD(db0, db1, 5));   DGAP(2, pw0, dc0, dc1, VRD(dc0, dc1, 6));   DGAP(3, pw0, dd0, dd1, VRD(dd0, dd1, 7));
        DGAP(4, pw1, da0, da1, VRD(da0, da1, 8));   DGAP(5, pw1, db0, db1, VRD(db0, db1, 9));   DGAP(6, pw1, dc0, dc1, VRD(dc0, dc1, 10));  DGAP(7, pw1, dd0, dd1, VRD(dd0, dd1, 11));
        DGAP(8, pw2, da0, da1, VRD(da0, da1, 12));  DGAP(9, pw2, db0, db1, VRD(db0, db1, 13));  DGAP(10, pw2, dc0, dc1, VRD(dc0, dc1, 14)); DGAP(11, pw2, dd0, dd1, VRD(dd0, dd1, 15));
        DGAP(12, pw3, da0, da1, (void)0);           DGAP(13, pw3, db0, db1, (void)0);           DGAP(14, pw3, dc0, dc1, (void)0);           DGAP(15, pw3, dd0, dd1, (void)0);
#undef DGAP
    }
    l_reg = half_sum(l_reg);
    if (hi == 0) wsf[32 + r32] = 1.0f / l_reg;
    asm volatile("s_waitcnt lgkmcnt(0)" ::: "memory");
#pragma unroll
    for (int r = 0; r < 16; ++r) { const float il = wsf[32 + crow(r, hi)];
#pragma unroll
        for (int d = 0; d < 4; ++d) o[d][r] *= il; }
    WAIT_BAR(0);
#define LBAR() asm volatile("s_waitcnt lgkmcnt(0)\n\ts_barrier" ::: "memory")
    if (nqb >= 0) {
        const unsigned short* nk = P.kt + (size_t)(nb * NH + nh) * 64 * 8192 + wid * 512 + lane * 8;
        const unsigned short* nv = P.vt + (size_t)(nb * NH + nh) * 64 * 8192 + wid * 512 + lane * 8;
        glds16(nk, (unsigned)__builtin_amdgcn_readfirstlane(kdst)); glds16(nk + 4096, (unsigned)__builtin_amdgcn_readfirstlane(kdst + 8192));
        glds16(nv, (unsigned)__builtin_amdgcn_readfirstlane(vdst)); glds16(nv + 4096, (unsigned)__builtin_amdgcn_readfirstlane(vdst + 8192));
        glds16(nk + 8192, (unsigned)__builtin_amdgcn_readfirstlane(kdst + SLOTB)); glds16(nk + 8192 + 4096, (unsigned)__builtin_amdgcn_readfirstlane(kdst + 8192 + SLOTB));
        if (nqb > 0) { glds16(nk + 2 * 8192, (unsigned)__builtin_amdgcn_readfirstlane(kdst + 2 * SLOTB)); glds16(nk + 2 * 8192 + 4096, (unsigned)__builtin_amdgcn_readfirstlane(kdst + 8192 + 2 * SLOTB)); }
    }
    const lds_fptr cmb = (lds_fptr)(lds + LDS_CMB) + rg * 4096;
    if (map == 1) {
#pragma unroll
        for (int d = 0; d < 4; ++d)
#pragma unroll
            for (int r = 0; r < 16; ++r) cmb[crow(r, hi) * 128 + d * 32 + r32] = o[d][r];
    }
    LBAR();
    if (map == 0) {
        const float lam = P.lam;
        float gsub[4];
#pragma unroll
        for (int d = 0; d < 4; ++d) gsub[d] = P.subln_g[d * 32 + r32];
        f32x16 sq;
#pragma unroll
        for (int r = 0; r < 16; ++r) sq[r] = 0.f;
#pragma unroll
        for (int d = 0; d < 4; ++d) {
            f32x16 c;
#pragma unroll
            for (int r = 0; r < 16; ++r) c[r] = cmb[crow(r, hi) * 128 + d * 32 + r32];
            PIN(c);
#pragma unroll
            for (int r = 0; r < 16; ++r) { const float v = o[d][r] - lam * c[r]; o[d][r] = v; sq[r] += v * v; }
        }
#pragma unroll
        for (int s = 1; s < 32; s <<= 1) {
            f32x16 t;
#pragma unroll
            for (int r = 0; r < 16; ++r) t[r] = __shfl_xor(sq[r], s);
            PIN(t);
#pragma unroll
            for (int r = 0; r < 16; ++r) sq[r] += t[r];
        }
#pragma unroll
        for (int r = 0; r < 16; ++r) sq[r] = __builtin_amdgcn_rsqf(sq[r] * (1.0f / 128.0f) + SUBLN_EPS) * (1.0f - P.lam_init);
        asm volatile("s_waitcnt lgkmcnt(0)" ::: "memory");
        __attribute__((address_space(3))) unsigned short* ot = (__attribute__((address_space(3))) unsigned short*)cmb;
#pragma unroll
        for (int r = 0; r < 16; ++r) {
#pragma unroll
            for (int d = 0; d < 4; ++d) { const float v = o[d][r] * sq[r] * gsub[d]; ot[crow(r, hi) * 128 + d * 32 + r32] = (unsigned short)(cvtpk(v, v) & 0xffffu); }
        }
    }
    LBAR();
    {
#pragma unroll
        for (int i = 0; i < 4; ++i) { const int c = tid + i * 512, row = c >> 4, ch = c & 15;
            const __attribute__((address_space(3))) unsigned short* ot = (const __attribute__((address_space(3))) unsigned short*)(lds + LDS_CMB + (row >> 5) * 16384) + (row & 31) * 128 + ch * 8;
            pg8::st16(P.mix + (rowbase + q0 + row) * DM + h * 128 + ch * 8, *(const __attribute__((address_space(3))) u32x4*)ot); }
    }
    LBAR();
#undef LBAR
#undef DMA_K
#undef DMA_V
#undef BAND
#undef RESC
#undef ROT
#undef PKW
#undef VFRAG
#undef VRD
#undef GAPA
#undef KRD
#undef GAPB
#undef STEP
#undef ENDW
}
#undef SBAR
#undef PIN
#undef WAIT_BAR
#undef MFMA
#undef MX3
#undef EX
}
#define LAS __attribute__((address_space(3)))
typedef unsigned short bf16;
typedef unsigned v4u __attribute__((ext_vector_type(4)));
typedef float f32x4 __attribute__((ext_vector_type(4)));
constexpr int NWAVES = 8;
constexpr int RING_BYTES = 131072, LDS_BYTES = 147456;
constexpr int NPHASE = 12;
constexpr size_t MiB = 1u << 20;
constexpr size_t WS_W = 2 * MiB;
constexpr size_t W_IN = 0, W_O = 5 * MiB, W_GU = 7 * MiB, W_D = 18 * MiB, W_P = 18 * MiB + 5632 * 1024, W_LAYER = 24 * MiB;
constexpr size_t WS_SSQ = 50 * MiB, WS_XB = 52 * MiB, WS_PROJ = 116 * MiB, WS_MIX = 276 * MiB, WS_H = 116 * MiB, WS_KT = 340 * MiB, WS_VT = 372 * MiB, WS_END = 404 * MiB;
static_assert(WS_W + 2 * W_LAYER <= WS_SSQ && WS_SSQ + (size_t)M * 16 * 4 <= WS_XB && WS_XB + (size_t)M * DM * 2 <= WS_PROJ && WS_PROJ + (size_t)M * INC * 2 <= WS_MIX &&
              WS_MIX + (size_t)M * DM * 2 <= WS_KT && WS_H + (size_t)M * DFF * 2 <= WS_KT && WS_KT + (size_t)M * 512 * 2 <= WS_VT && WS_VT + (size_t)M * 512 * 2 <= WS_END, "d_ws map");

__device__ __forceinline__ unsigned f2bf(float f) { unsigned u = __builtin_bit_cast(unsigned, f); return (u + 0x7fffu + ((u >> 16) & 1u)) >> 16; }
__device__ __forceinline__ unsigned pk2(float lo, float hi) { return f2bf(lo) | (f2bf(hi) << 16); }
__device__ __forceinline__ float bf2f(unsigned short v) { return __builtin_bit_cast(float, (unsigned)v << 16); }
__device__ __forceinline__ float wave_sum(float v) {
#pragma unroll
    for (int o = 1; o < 64; o <<= 1) v += __shfl_xor(v, o);
    return v;
}
#define LDS_WAIT() asm volatile("s_waitcnt lgkmcnt(0)" ::: "memory")

#ifndef PREFIX
#define PREFIX 99
#endif
#ifndef COOP_LAUNCH
#define COOP_LAUNCH 0
#endif
#ifndef ONE_LAUNCH
#define ONE_LAUNCH 1
#endif

struct Args { const float* in[18]; float* out; unsigned char* ws; int ph_lo, ph_hi, use_sync, pad; };
typedef const Args __attribute__((address_space(4)))* KArgsP;
__device__ __forceinline__ int s_opaque(int v) { asm volatile("" : "+s"(v)); return v; }
#define GDX() s_opaque((int)gridDim.x)
#define BIX() s_opaque((int)blockIdx.x)
__device__ __forceinline__ KArgsP kargs() { KArgsP p = (KArgsP)__builtin_amdgcn_kernarg_segment_ptr(); asm volatile("" : "+s"(p)); return p; }

__device__ __forceinline__ void transpose_item(const float* W, int K, int N, const float* gk, bf16* WT, int k0, int n0, int out_row0, LAS float* scr, int lane) {
    float v[32];
    const float* wp = W + (size_t)(k0 + (lane >> 5)) * N + n0 + (lane & 31);
#pragma unroll
    for (int i = 0; i < 32; ++i) v[i] = __builtin_nontemporal_load(wp + (size_t)(2 * i) * N);
    if (gk) {
#pragma unroll
        for (int i = 0; i < 32; ++i) v[i] *= gk[k0 + 2 * i + (lane >> 5)];
    }
#pragma unroll
    for (int i = 0; i < 32; ++i) scr[(2 * i + (lane >> 5)) * 33 + (lane & 31)] = v[i];
    LDS_WAIT(); asm volatile("" ::: "memory");
    const int c = lane & 7;
#pragma unroll
    for (int j = 0; j < 4; ++j) { const int n = (lane >> 3) + 8 * j; const LAS float* s = scr + (8 * c) * 33 + n;
        v4u o; o.x = pk2(s[0 * 33], s[1 * 33]); o.y = pk2(s[2 * 33], s[3 * 33]); o.z = pk2(s[4 * 33], s[5 * 33]); o.w = pk2(s[6 * 33], s[7 * 33]);
        pg8::st16(WT + (size_t)(out_row0 + n) * K + k0 + 8 * c, o); }
    LDS_WAIT(); asm volatile("" ::: "memory");
}

__device__ __forceinline__ void phase_prologue(KArgsP ap, unsigned char* ws_, LAS unsigned char* lds, int vcu, int G, int wave, int lane) {
    LAS float* scr = (LAS float*)(lds + wave * 16384);
    const int gw = vcu * NWAVES + wave, NGW = G * NWAVES;
    constexpr int I_IN = (DM / 64) * (INC / 32), I_O = (DM / 64) * (DM / 32), I_G = (DM / 64) * (DFF / 32), I_D = (DFF / 64) * (DM / 32), I_P = 4;
    constexpr int I_LAYER = I_IN + I_O + 2 * I_G + I_D + I_P;
    for (int it = gw; it < DEPTH * I_LAYER; it += NGW) {
        const int l = it / I_LAYER; int r = it % I_LAYER;
        bf16* wl = (bf16*)(ws_ + WS_W + (size_t)l * W_LAYER);
        if (r < I_IN) { const int nb = INC / 32, k0 = 64 * (r / nb), n0 = 32 * (r % nb);
            transpose_item(ap->in[2] + (size_t)l * DM * INC, DM, INC, ap->in[1] + l * DM, (bf16*)((char*)wl + W_IN), k0, n0, n0, scr, lane); continue; } r -= I_IN;
        if (r < I_O) { const int nb = DM / 32, k0 = 64 * (r / nb), n0 = 32 * (r % nb);
            transpose_item(ap->in[12] + (size_t)l * DM * DM, DM, DM, nullptr, (bf16*)((char*)wl + W_O), k0, n0, n0, scr, lane); continue; } r -= I_O;
        if (r < 2 * I_G) { const int up = r >= I_G; if (up) r -= I_G; const int nb = DFF / 32, k0 = 64 * (r / nb), n0 = 32 * (r % nb);
            transpose_item(ap->in[up ? 15 : 14] + (size_t)l * DM * DFF, DM, DFF, ap->in[13] + l * DM, (bf16*)((char*)wl + W_GU), k0, n0, 256 * (n0 / 128) + (n0 % 128) + (up ? 128 : 0), scr, lane); continue; } r -= 2 * I_G;
        if (r < I_D) { const int nb = DM / 32, k0 = 64 * (r / nb), n0 = 32 * (r % nb);
            transpose_item(ap->in[16] + (size_t)l * DFF * DM, DFF, DM, nullptr, (bf16*)((char*)wl + W_D), k0, n0, n0, scr, lane); continue; } r -= I_D;
        {
            const float* wsrc = ap->in[9] + ((size_t)l * 4 + r) * 64 * 64; bf16* wdst = (bf16*)((char*)wl + W_P) + (size_t)r * 64 * 64;
            transpose_item(wsrc, 64, 64, nullptr, wdst, 0, 0, 0, scr, lane); transpose_item(wsrc, 64, 64, nullptr, wdst, 0, 32, 32, scr, lane);
        }
    }
    bf16* XB = (bf16*)(ws_ + WS_XB); float* SSQ = (float*)(ws_ + WS_SSQ);
    for (int m0 = gw * 8; m0 < M; m0 += NGW * 8) {
        f32x4 v[8][4];
#pragma unroll
        for (int q = 0; q < 8; ++q) { const f32x4* xr = (const f32x4*)(ap->in[0] + (size_t)(m0 + q) * DM) + lane;
#pragma unroll
            for (int j = 0; j < 4; ++j) v[q][j] = __builtin_nontemporal_load(xr + 64 * j); }
#pragma unroll
        for (int q = 0; q < 8; ++q) {
            float s = 0.f;
#pragma unroll
            for (int j = 0; j < 4; ++j) s += (v[q][j][0] * v[q][j][0] + v[q][j][1] * v[q][j][1]) + (v[q][j][2] * v[q][j][2] + v[q][j][3] * v[q][j][3]);
            s = wave_sum(s);
            unsigned long long* o8 = (unsigned long long*)(XB + (size_t)(m0 + q) * DM) + lane;
#pragma unroll
            for (int j = 0; j < 4; ++j) o8[64 * j] = (unsigned long long)pk2(v[q][j][0], v[q][j][1]) | ((unsigned long long)pk2(v[q][j][2], v[q][j][3]) << 32);
            if (lane < 4) SSQ[(size_t)(m0 + q) * 4 + lane] = (lane == 0) ? s : 0.f;
        }
    }
}

typedef short pc_bf16x8 __attribute__((ext_vector_type(8)));
typedef float pc_f32x16 __attribute__((ext_vector_type(16)));
template <int W>
__device__ __forceinline__ void pooled_block(const LAS unsigned* Ps32, LAS unsigned* At32, int tb, int g, int cp, int t0) {
    float lo[15 + W], hi[15 + W];
    unsigned raw[15 + W];
#pragma unroll
    for (int i = 0; i < 15 + W; ++i) raw[i] = Ps32[(16 * tb + 16 - W + i) * 128 + 32 * g + cp];
#pragma unroll
    for (int i = 0; i < 15 + W; ++i) asm volatile("" : "+v"(raw[i]));
#pragma unroll
    for (int i = 0; i < 15 + W; ++i) { const unsigned u = raw[i]; lo[i] = __builtin_bit_cast(float, u << 16); hi[i] = __builtin_bit_cast(float, u & 0xffff0000u); }
    float sl = 0.f, sh = 0.f;
#pragma unroll
    for (int i = 0; i < W; ++i) { sl += lo[i]; sh += hi[i]; }
#pragma unroll
    for (int i = 0; i < 16; ++i) {
        const int t = t0 + 16 * tb + i;
        const float inv = 1.0f / (float)((t + 1) < W ? (t + 1) : W);
        const float pl = sl * inv - lo[W - 1 + i], ph = sh * inv - hi[W - 1 + i];
        At32[(16 * tb + i) * 132 + 32 * g + cp] = pk2(pl, ph);
        if (i < 15) { sl += lo[W + i] - lo[i]; sh += hi[W + i] - hi[i]; }
    }
}
__device__ __forceinline__ void poolconv_unit(int u, const bf16* PROJ, bf16* MIX, const bf16* WpT, const float* pool_scale, const float* conv_w, LAS unsigned char* lds) {
    int tid_ = threadIdx.x; asm volatile("" : "+v"(tid_));
    const int tid = tid_, lane = tid & 63, wave = __builtin_amdgcn_readfirstlane(tid >> 6);
    const size_t R0 = (size_t)u * 64; const int t0 = (int)(R0 % SEQ);
    LAS bf16* Ps = (LAS bf16*)lds;
    LAS unsigned char* At = lds + 40960;
    LAS bf16* Ot = (LAS bf16*)(lds + 40960 + 33792);
    pc_bf16x8 bfr[2][4]; float psc[2];
    { const int g = wave & 3, r32 = lane & 31, hi = lane >> 5;
#pragma unroll
      for (int cb = 0; cb < 2; ++cb) { psc[cb] = pool_scale[g * 64 + cb * 32 + r32];
#pragma unroll
          for (int ks = 0; ks < 4; ++ks) bfr[cb][ks] = *(const pc_bf16x8*)(WpT + ((size_t)(g * 64 + cb * 32 + r32)) * 64 + ks * 16 + 8 * hi); } }
    v4u sv[5];
#pragma unroll
    for (int k = 0; k < 5; ++k) { const int c = tid + k * 512, j = c >> 5, ch8 = c & 31; const bool ok = (c < 79 * 32) && (t0 - 15 + j >= 0);
        sv[k] = __builtin_nontemporal_load((const v4u*)(PROJ + (ok ? R0 - 15 + j : R0) * INC + C_P + ch8 * 8)); }
    {
        const int tr = tid >> 5, cg8 = (tid & 31) * 8;
        float w0[8], w1[8], w2[8];
#pragma unroll
        for (int e = 0; e < 8; ++e) { w0[e] = conv_w[cg8 + e]; w1[e] = conv_w[256 + cg8 + e]; w2[e] = conv_w[512 + cg8 + e]; }
        v4u gc[6], hn[6], gb[4];
#pragma unroll
        for (int i = 0; i < 6; ++i) { const int tl = tr * 4 + i - 2; const size_t row = (t0 + tl >= 0) ? R0 + tl : R0;
            gc[i] = __builtin_nontemporal_load((const v4u*)(PROJ + row * INC + C_GC + cg8)); hn[i] = __builtin_nontemporal_load((const v4u*)(PROJ + row * INC + C_HIN + cg8)); }
#pragma unroll
        for (int i = 0; i < 4; ++i) gb[i] = __builtin_nontemporal_load((const v4u*)(PROJ + (R0 + tr * 4 + i) * INC + C_GB + cg8));
#pragma unroll
        for (int k = 0; k < 5; ++k) { const int c = tid + k * 512, j = c >> 5, ch8 = c & 31;
            if (c < 79 * 32) *(LAS v4u*)(Ps + j * 256 + ch8 * 8) = (t0 - 15 + j >= 0) ? sv[k] : (v4u){0u, 0u, 0u, 0u}; }
#pragma unroll
        for (int i = 0; i < 2; ++i) if (t0 + tr * 4 + i - 2 < 0) gc[i] = (v4u){0u, 0u, 0u, 0u};
        float uu[6][8];
#pragma unroll
        for (int i = 0; i < 6; ++i)
#pragma unroll
            for (int e = 0; e < 4; ++e) { uu[i][2 * e] = __builtin_bit_cast(float, gc[i][e] << 16) * __builtin_bit_cast(float, hn[i][e] << 16);
                uu[i][2 * e + 1] = __builtin_bit_cast(float, gc[i][e] & 0xffff0000u) * __builtin_bit_cast(float, hn[i][e] & 0xffff0000u); }
#pragma unroll
        for (int i = 0; i < 4; ++i) {
            v4u o;
#pragma unroll
            for (int e = 0; e < 4; ++e) {
                const float y0 = w0[2 * e] * uu[i][2 * e] + w1[2 * e] * uu[i + 1][2 * e] + w2[2 * e] * uu[i + 2][2 * e];
                const float y1 = w0[2 * e + 1] * uu[i][2 * e + 1] + w1[2 * e + 1] * uu[i + 1][2 * e + 1] + w2[2 * e + 1] * uu[i + 2][2 * e + 1];
                o[e] = pk2(__builtin_bit_cast(float, gb[i][e] << 16) * y0, __builtin_bit_cast(float, gb[i][e] & 0xffff0000u) * y1); }
            pg8::st16(MIX + (R0 + tr * 4 + i) * DM + 768 + cg8, o);
        }
    }
    __syncthreads();
    {
        const int g = wave & 3, tb = (lane >> 5) + 2 * (wave >> 2), cp = lane & 31;
        const LAS unsigned* Ps32 = (const LAS unsigned*)lds; LAS unsigned* At32 = (LAS unsigned*)At;
        if (g == 0) pooled_block<2>(Ps32, At32, tb, 0, cp, t0);
        else if (g == 1) pooled_block<4>(Ps32, At32, tb, 1, cp, t0);
        else if (g == 2) pooled_block<8>(Ps32, At32, tb, 2, cp, t0);
        else pooled_block<16>(Ps32, At32, tb, 3, cp, t0);
    }
    __syncthreads();
    {
        const int g = wave & 3, rb = wave >> 2, r32 = lane & 31, hi = lane >> 5;
        pc_f32x16 acc[2];
#pragma unroll
        for (int cb = 0; cb < 2; ++cb)
#pragma unroll
            for (int r = 0; r < 16; ++r) acc[cb][r] = 0.f;
#pragma unroll
        for (int ks = 0; ks < 4; ++ks) {
            const pc_bf16x8 af = *(const LAS pc_bf16x8*)(At + (32 * rb + r32) * 528 + (g * 64 + ks * 16 + 8 * hi) * 2);
#pragma unroll
            for (int cb = 0; cb < 2; ++cb) {
                acc[cb] = __builtin_amdgcn_mfma_f32_32x32x16_bf16(af, bfr[cb][ks], acc[cb], 0, 0, 0);
            }
        }
#pragma unroll
        for (int cb = 0; cb < 2; ++cb) { const float ps = psc[cb];
#pragma unroll
            for (int r = 0; r < 16; ++r) Ot[(32 * rb + (r & 3) + 8 * (r >> 2) + 4 * hi) * 256 + g * 64 + cb * 32 + r32] = (bf16)f2bf(acc[cb][r] * ps); }
    }
    __syncthreads();
    for (int c = tid; c < 64 * 32; c += 512) { const int row = c >> 5, ch8 = c & 31; pg8::st16(MIX + (R0 + row) * DM + 512 + ch8 * 8, *(const LAS v4u*)(Ot + row * 256 + ch8 * 8)); }
    __syncthreads();
}

typedef __attribute__((address_space(1))) unsigned gu32;
#define RLX_AGENT __ATOMIC_RELAXED, __HIP_MEMORY_SCOPE_AGENT
constexpr size_t WS_CTL = 0, CTL_ZERO_BYTES = 65536;
constexpr int MISC_OFF = RING_BYTES + 320;
#define XB_TMO      128
#define XB_XCNT(j)  (256  + 64 * (j))
#define XB_XSUB(j)  (1280 + 64 * (j))
#define XB_XGEN(j)  (2304 + 64 * (j))
#define XB_TOP      3328
#define XB_TOPGEN   3392
#define XCD_BAR_WORDS 3456
#define XB_SPIN_CAP (1u << 18)

__device__ __forceinline__ unsigned xb_ld(unsigned* p)              { return __hip_atomic_load(p, __ATOMIC_RELAXED, __HIP_MEMORY_SCOPE_AGENT); }
__device__ __forceinline__ unsigned xb_add(unsigned* p, unsigned v) { return __hip_atomic_fetch_add(p, v, __ATOMIC_RELAXED, __HIP_MEMORY_SCOPE_AGENT); }
__device__ __forceinline__ unsigned xb_xcc_id() { return (unsigned)__builtin_amdgcn_s_getreg((3 << 11) | 20) & 0xFu; }
#define XB_SPIN(cond, bar) do { unsigned _sp = 0; while (cond) { __builtin_amdgcn_s_sleep(1); \
    if ((++_sp & 255u) == 0u) { if (xb_ld(&(bar)[XB_TMO])) break; if (_sp > XB_SPIN_CAP) { atomicAdd(&(bar)[XB_TMO], 1u); break; } } } } while (0)

struct XcdBarrier {
    unsigned* bar; unsigned x;
    volatile LAS unsigned* st;
};

__device__ __forceinline__ XcdBarrier xcd_barrier_post(unsigned* bar, volatile LAS unsigned* st) {
    XcdBarrier b; b.bar = bar; b.x = xb_xcc_id(); b.st = st;
    if (threadIdx.x == 0) (void)xb_add(&bar[XB_XCNT(b.x)], 1u);
    return b;
}
__device__ __forceinline__ void xcd_barrier_complete(unsigned* bar, unsigned x, unsigned& nloc, unsigned& nx) {
    const unsigned G = gridDim.x * gridDim.y * gridDim.z;
    unsigned sum, cnt, mine, sp = 0u;
    for (;;) {
        sum = 0u; cnt = 0u; mine = 0u;
#pragma unroll
        for (unsigned j = 0; j < 16; ++j) { const unsigned c = xb_ld(&bar[XB_XCNT(j)]); sum += c; cnt += (c > 0u) ? 1u : 0u; }
        mine = xb_ld(&bar[XB_XCNT(x)]);
        if (sum == G) break;
        __builtin_amdgcn_s_sleep(1);
        if ((++sp & 255u) == 0u) { if (xb_ld(&bar[XB_TMO])) break; if (sp > XB_SPIN_CAP) { atomicAdd(&bar[XB_TMO], 1u); break; } }
    }
    nloc = mine > 0u ? mine : 1u; nx = cnt > 0u ? cnt : 1u;
}

__device__ __forceinline__ void xcd_barrier(const XcdBarrier& b) {
    asm volatile("s_waitcnt vmcnt(0)" ::: "memory");
    __syncthreads();
    if (threadIdx.x == 0) {
        unsigned* bar = b.bar;
        __builtin_amdgcn_s_waitcnt(0);
        unsigned nloc = b.st[0], nx = b.st[1];
        if (nloc == 0u) { xcd_barrier_complete(bar, b.x, nloc, nx); b.st[0] = nloc; b.st[1] = nx; }
        const unsigned old = xb_add(&bar[XB_XSUB(b.x)], 1u);
        const unsigned gen = old / nloc;
        if (old + 1u == (gen + 1u) * nloc) {
            __builtin_amdgcn_fence(__ATOMIC_RELEASE, "agent");
            asm volatile("s_waitcnt vmcnt(0)" ::: "memory");
            const unsigned og = xb_add(&bar[XB_TOP], 1u);
            const unsigned tg = og / nx;
            if (og + 1u == (tg + 1u) * nx) xb_add(&bar[XB_TOPGEN], 1u);
            else XB_SPIN(xb_ld(&bar[XB_TOPGEN]) == tg, bar);
            __builtin_amdgcn_fence(__ATOMIC_ACQUIRE, "agent");
            xb_add(&bar[XB_XGEN(b.x)], 1u);
            asm volatile("s_waitcnt vmcnt(0)" ::: "memory");
        } else {
            XB_SPIN(xb_ld(&bar[XB_XGEN(b.x)]) == gen, bar);
            __builtin_amdgcn_fence(__ATOMIC_ACQUIRE, "agent");
            asm volatile("s_waitcnt vmcnt(0)" ::: "memory");
        }
    }
    __syncthreads();
}

template <int NIT>
__device__ __forceinline__ void build_rtab(LAS float* rtab, const float* ssq, const pg8::StaticOrder& S) {
    int t_ = threadIdx.x; asm volatile("" : "+v"(t_));
    const int lim = ((S.nwg + S.G - 1) / S.G) * 256;
    f32x4 a[NIT];
#pragma unroll
    for (int k = 0; k < NIT; ++k) { const int idx = t_ + k * (NWAVES * 64); pg8::Unit u; u.pm = 0; u.pn = 0; (void)S.next(idx < lim ? idx >> 8 : 0, u);
        a[k] = *(const f32x4*)(ssq + (size_t)(u.pm * 256 + (idx & 255)) * 4); }
#pragma unroll
    for (int k = 0; k < NIT; ++k) { const int idx = t_ + k * (NWAVES * 64); pg8::Unit u;
        if (idx < lim && S.next(idx >> 8, u)) rtab[idx] = 1.0f / sqrtf(((a[k][0] + a[k][1]) + (a[k][2] + a[k][3])) * (1.0f / 1024.0f) + 1e-6f); }
    for (int idx = t_ + NIT * (NWAVES * 64); idx < lim; idx += NWAVES * 64) { pg8::Unit u; if (S.next(idx >> 8, u)) rtab[idx] = pg8::row_rstd(ssq, u.pm * 256 + (idx & 255)); }
    __syncthreads();
}
__device__ __forceinline__ int vcu_of(int g, int b) { return (g % 8 == 0) ? (b % 8) * (g / 8) + b / 8 : b; }
__global__ void __launch_bounds__(NWAVES * 64, 2) mega_fwd(Args args) {
    extern __shared__ __attribute__((aligned(16))) unsigned char lds_raw[];
    LAS unsigned char* lds = (LAS unsigned char*)lds_raw;
    const int lo = args.ph_lo, hi = args.ph_hi;
    { int t_ = threadIdx.x; asm volatile("" : "+v"(t_)); for (int u = t_; u < (LDS_BYTES - RING_BYTES) / 4; u += NWAVES * 64) ((LAS unsigned*)(lds + RING_BYTES))[u] = 0u; }
    __syncthreads();
    XcdBarrier bar; bar.bar = (unsigned*)(args.ws + WS_CTL); bar.x = 0; bar.st = nullptr;
    if (args.use_sync & 1) bar = xcd_barrier_post((unsigned*)(args.ws + WS_CTL), (volatile LAS unsigned*)(lds + MISC_OFF) + 8);
    const bool fuse_final = (gridDim.x == 256u) && (lo <= NPHASE - 2) && (hi == NPHASE);
#define IN(k) (lo <= (k) && (k) < hi)
#ifndef EN_MASK
#define EN_MASK 0x1ff
#endif
#define EN(b) ((EN_MASK >> (b)) & 1)
#ifndef BARX
#define BARX 1
#endif
#define SEAM(k) do { if (IN(k) && IN((k) + 1)) { if (args.use_sync & 1) { _Pragma("unroll 1") for (int bx_ = 0; bx_ < BARX; ++bx_) xcd_barrier(bar); } } } while (0)
#define VCU() vcu_of(GDX(), BIX())
    if (EN(0) && IN(0)) {
        int t_ = threadIdx.x; asm volatile("" : "+v"(t_));
        phase_prologue(kargs(), args.ws, lds, VCU(), GDX(), __builtin_amdgcn_readfirstlane(t_ >> 6), t_ & 63);
    }
    SEAM(0);
#pragma unroll 1
    for (int l = 0; l < DEPTH; ++l) {
        const int p0 = 1 + 5 * l;
        if (EN(1) && IN(p0)) {
            unsigned char* ws = args.ws;
            pg8::Gemm g{(const bf16*)(ws + WS_XB), (const bf16*)(ws + WS_W + (size_t)l * W_LAYER + W_IN), M, INC, DM}; pg8::StaticOrder S; S.init(M, INC, GDX(), BIX());
            LAS float* rtab = (LAS float*)(lds + RING_BYTES + 1024);
            build_rtab<(INC / 256 * (M / 256) / 256 + 1) / 2>(rtab, (const float*)(ws + WS_SSQ), S);
            pg8::EpiProj E{(bf16*)(ws + WS_PROJ), (bf16*)(ws + WS_KT), (bf16*)(ws + WS_VT), rtab, INC, QSCALE, args.use_sync & (8 | 16 | 32)};
            pg8::gemm_phase<pg8::EpiProj, pg8::StaticOrder, PG8_ALIGN, PG8_SP2>(lds, g, S, E);
        }
        SEAM(p0);
        if (EN(2) && IN(p0 + 1)) {
            unsigned char* ws = args.ws;
            int t_ = threadIdx.x; asm volatile("" : "+v"(t_));
            const int lane = t_ & 63, vcu = VCU(), G = GDX();
            att3::Params P; P.proj = (const bf16*)(ws + WS_PROJ); P.kt = (const bf16*)(ws + WS_KT); P.vt = (const bf16*)(ws + WS_VT); P.mix = (bf16*)(ws + WS_MIX); P.rel_bias = kargs()->in[8]; P.subln_g = kargs()->in[7] + l * 128;
            P.lam_init = 0.8f - 0.6f * __expf(-0.3f * (float)l);
            { const float a1 = wave_sum(kargs()->in[3][l * 64 + lane] * kargs()->in[4][l * 64 + lane]), a2 = wave_sum(kargs()->in[5][l * 64 + lane] * kargs()->in[6][l * 64 + lane]);
              P.lam = __expf(a1) - __expf(a2) + P.lam_init; }
            if (EN(7) && !(args.use_sync & 2)) {
                const int nun = (G == 256) ? 4 : (BATCH * NH * 32 - vcu + G - 1) / G;
                int pbh = -1;
#pragma unroll 1
                for (int i = 0; i < nun; ++i) {
                    int bh, qb, nbh = 0, nqb = -1;
                    if (G == 256) { const int s = vcu & 7; bh = vcu >> 3; qb = (i == 0) ? s : (i == 1) ? 15 - s : (i == 2) ? 16 + s : 31 - s;
                        if (i + 1 < nun) { nbh = bh; nqb = (i == 0) ? 15 - s : (i == 1) ? 16 + s : 31 - s; } }
                    else { const int un = vcu + i * G; bh = un >> 5; qb = un & 31; if (i + 1 < nun) { nbh = (un + G) >> 5; nqb = (un + G) & 31; } }
                    att3::attn_unit<8>(bh >> 2, bh & 3, qb, i > 0, (i == 0) || (bh != pbh), nbh >> 2, nbh & 3, nqb, P, (att3::lds_ptr)lds); pbh = bh;
                }
            }
#pragma unroll 1
            for (int un = vcu; EN(8) && !(args.use_sync & 4) && un < M / 64; un += G) poolconv_unit(un, (const bf16*)(ws + WS_PROJ), (bf16*)(ws + WS_MIX), (const bf16*)(ws + WS_W + (size_t)l * W_LAYER + W_P), kargs()->in[10] + l * 256, kargs()->in[11] + l * 768, lds);
        }
        SEAM(p0 + 1);
        if (EN(3) && IN(p0 + 2)) {
            unsigned char* ws = args.ws;
            pg8::Gemm g{(const bf16*)(ws + WS_MIX), (const bf16*)(ws + WS_W + (size_t)l * W_LAYER + W_O), M, DM, DM}; pg8::StaticOrder S; S.init(M, DM, GDX(), BIX());
            pg8::EpiRes E{(bf16*)(ws + WS_XB), (float*)(ws + WS_SSQ), (LAS float*)(lds + RING_BYTES + 4096)};
            pg8::gemm_phase<pg8::EpiRes, pg8::StaticOrder, PG8_ALIGN, PG8_SP2>(lds, g, S, E);
        }
        SEAM(p0 + 2);
        if (EN(4) && IN(p0 + 3)) {
            unsigned char* ws = args.ws;
            pg8::Gemm g{(const bf16*)(ws + WS_XB), (const bf16*)(ws + WS_W + (size_t)l * W_LAYER + W_GU), M, NGU, DM}; pg8::StaticOrder S; S.init(M, NGU, GDX(), BIX());
            LAS float* rtab = (LAS float*)(lds + RING_BYTES + 1024);
            build_rtab<(NGU / 256 * (M / 256) / 256 + 1) / 2>(rtab, (const float*)(ws + WS_SSQ), S);
            pg8::EpiSwiGLU E{(bf16*)(ws + WS_H), rtab, DFF, args.use_sync & 8};
            pg8::gemm_phase<pg8::EpiSwiGLU, pg8::StaticOrder, PG8_ALIGN, PG8_SP2>(lds, g, S, E);
        }
        SEAM(p0 + 3);
        if (EN(5) && IN(p0 + 4)) {
            unsigned char* ws = args.ws;
            pg8::Gemm g{(const bf16*)(ws + WS_H), (const bf16*)(ws + WS_W + (size_t)l * W_LAYER + W_D), M, DM, DFF}; pg8::StaticOrder S; S.init(M, DM, GDX(), BIX());
            if (l == DEPTH - 1 && fuse_final) {
                pg8::EpiResFinal E{(const bf16*)(ws + WS_XB), (float*)(ws + WS_SSQ), kargs()->out, kargs()->in[17], (unsigned*)(ws + 32768), (LAS float*)(lds + RING_BYTES + 4096)};
                pg8::gemm_phase<pg8::EpiResFinal, pg8::StaticOrder, PG8_ALIGN, PG8_SP2>(lds, g, S, E);
            } else {
                pg8::EpiRes E{(bf16*)(ws + WS_XB), (float*)(ws + WS_SSQ), (LAS float*)(lds + RING_BYTES + 4096)};
                pg8::gemm_phase<pg8::EpiRes, pg8::StaticOrder, PG8_ALIGN, PG8_SP2>(lds, g, S, E);
            }
        }
        if (!(l == DEPTH - 1 && fuse_final)) SEAM(p0 + 4);
    }
    if (EN(6) && IN(NPHASE - 1) && !fuse_final) {
        int t_ = threadIdx.x; asm volatile("" : "+v"(t_));
        const int lane = t_ & 63, wave = __builtin_amdgcn_readfirstlane(t_ >> 6);
        const int gw = VCU() * NWAVES + wave, NGW = GDX() * NWAVES;
        const bf16* XBf = (const bf16*)(args.ws + WS_XB);
        typedef unsigned u32x2_t __attribute__((ext_vector_type(2)));
        f32x4 gf[4];
#pragma unroll
        for (int j = 0; j < 4; ++j) gf[j] = ((const f32x4*)kargs()->in[17])[lane + 64 * j];
        for (int m0 = gw * 8; m0 < M; m0 += NGW * 8) {
            u32x2_t raw[8][4];
#pragma unroll
            for (int q = 0; q < 8; ++q)
#pragma unroll
                for (int j = 0; j < 4; ++j) raw[q][j] = ((const u32x2_t*)(XBf + (size_t)(m0 + q) * DM))[lane + 64 * j];
#pragma unroll
            for (int q = 0; q < 8; ++q) {
                f32x4 v[4]; float s = 0.f;
#pragma unroll
                for (int j = 0; j < 4; ++j) { v[j][0] = __builtin_bit_cast(float, raw[q][j].x << 16); v[j][1] = __builtin_bit_cast(float, raw[q][j].x & 0xffff0000u);
                    v[j][2] = __builtin_bit_cast(float, raw[q][j].y << 16); v[j][3] = __builtin_bit_cast(float, raw[q][j].y & 0xffff0000u);
                    s += (v[j][0] * v[j][0] + v[j][1] * v[j][1]) + (v[j][2] * v[j][2] + v[j][3] * v[j][3]); }
                s = wave_sum(s);
                const float r = 1.0f / sqrtf(s * (1.0f / DM) + RMS_EPS);
                f32x4* orow = (f32x4*)(kargs()->out + (size_t)(m0 + q) * DM) + lane;
#pragma unroll
                for (int j = 0; j < 4; ++j) __builtin_nontemporal_store(v[j] * r * gf[j], orow + 64 * j);
            }
        }
    }
#undef IN
#undef SEAM
#undef VCU
}

#if PREFIX != 99
namespace ref {
typedef float f32x16 __attribute__((ext_vector_type(16)));
template <class T> __device__ __forceinline__ float ldf(const T* p, size_t i);
template <> __device__ __forceinline__ float ldf<float>(const float* p, size_t i) { return p[i]; }
template <> __device__ __forceinline__ float ldf<unsigned short>(const unsigned short* p, size_t i) { return bf2f(p[i]); }
__global__ void __launch_bounds__(256) k_rmsnorm(const float* x, const float* g, float* out, float eps) {
    const int wave = (blockIdx.x * 256 + threadIdx.x) >> 6, lane = threadIdx.x & 63;
    if (wave >= M) return;
    const float4* xr = (const float4*)(x + (size_t)wave * DM);
    const float4* gr = (const float4*)g;
    float4 v[4]; float s = 0.f;
#pragma unroll
    for (int j = 0; j < 4; ++j) { v[j] = xr[lane + 64 * j]; s += v[j].x * v[j].x + v[j].y * v[j].y + v[j].z * v[j].z + v[j].w * v[j].w; }
    s = wave_sum(s);
    const float r = 1.0f / sqrtf(s * (1.0f / DM) + eps);
    float4* orow = (float4*)(out + (size_t)wave * DM);
#pragma unroll
    for (int j = 0; j < 4; ++j) { const float4 gg = gr[lane + 64 * j]; float4 o; o.x = v[j].x * r * gg.x; o.y = v[j].y * r * gg.y; o.z = v[j].z * r * gg.z; o.w = v[j].w * r * gg.w; orow[lane + 64 * j] = o; }
}
template <int MODE, class TA>
__global__ void __launch_bounds__(256) k_gemm32(const TA* __restrict__ A, int lda, const float* __restrict__ W0, const float* __restrict__ W1, int ldw, float* C, int ldc, int K) {
    const int wave = threadIdx.x >> 6, lane = threadIdx.x & 63, r = lane & 31, h = lane >> 5;
    const int m0 = blockIdx.y * 128 + wave * 32;
    const int n0 = blockIdx.x * (MODE == 2 ? 32 : 64);
    f32x16 acc0, acc1;
#pragma unroll
    for (int i = 0; i < 16; ++i) { acc0[i] = 0.f; acc1[i] = 0.f; }
    const TA* ap = A + (size_t)(m0 + r) * lda + 8 * h;
    const float* b0p = W0 + (size_t)(8 * h) * ldw + n0 + r;
    const float* b1p = (MODE == 2) ? (W1 + (size_t)(8 * h) * ldw + n0 + r) : (W0 + (size_t)(8 * h) * ldw + n0 + 32 + r);
    for (int kb = 0; kb < K; kb += 16) {
        float av[8], bb0[8], bb1[8];
#pragma unroll
        for (int s = 0; s < 8; ++s) { av[s] = ldf<TA>(ap, kb + s); bb0[s] = b0p[(size_t)(kb + s) * ldw]; bb1[s] = b1p[(size_t)(kb + s) * ldw]; }
#pragma unroll
        for (int s = 0; s < 8; ++s) { acc0 = __builtin_amdgcn_mfma_f32_32x32x2f32(av[s], bb0[s], acc0, 0, 0, 0); acc1 = __builtin_amdgcn_mfma_f32_32x32x2f32(av[s], bb1[s], acc1, 0, 0, 0); }
    }
#pragma unroll
    for (int reg = 0; reg < 16; ++reg) {
        const int row = m0 + (reg & 3) + 8 * (reg >> 2) + 4 * h;
        float* cp = C + (size_t)row * ldc + n0 + r;
        if (MODE == 0) { cp[0] = acc0[reg]; cp[32] = acc1[reg]; }
        else if (MODE == 1) { cp[0] += acc0[reg]; cp[32] += acc1[reg]; }
        else { const float g = acc0[reg]; cp[0] = g / (1.0f + __expf(-g)) * acc1[reg]; }
    }
}
template <class T>
__global__ void __launch_bounds__(512) k_attn_naive(const T* __restrict__ proj, float qmul, const float* __restrict__ rel_bias,
                                                    const float* __restrict__ lq1, const float* __restrict__ lk1, const float* __restrict__ lq2, const float* __restrict__ lk2,
                                                    const float* __restrict__ subln_g, float lam_init, float* __restrict__ mixed) {
    __shared__ float sm[8192];
    __shared__ float ss[4][64];
    __shared__ float lam_s;
    float* Ks = sm; float* Vs = sm + 4096;
    const int tid = threadIdx.x, map = tid >> 8, quarter = (tid >> 6) & 3, ql = tid & 63;
    const int qb = blockIdx.x, h = blockIdx.y, b = blockIdx.z;
    const size_t rowbase = (size_t)b * SEQ;
    const int t = qb * 64 + ql;
    if (tid == 0) {
        float s1 = 0.f, s2 = 0.f;
        for (int i = 0; i < 64; ++i) { s1 += lq1[i] * lk1[i]; s2 += lq2[i] * lk2[i]; }
        lam_s = expf(s1) - expf(s2) + lam_init;
    }
    float q[64];
#pragma unroll
    for (int i = 0; i < 64; ++i) q[i] = ldf<T>(proj, (rowbase + t) * INC + C_Q + h * 128 + map * 64 + i) * qmul;
    float o[32];
#pragma unroll
    for (int i = 0; i < 32; ++i) o[i] = 0.f;
    float mrun = -1e30f, lrun = 0.f;
    const int nchunk = (qb * 64 + 64) / 32;
    for (int kc = 0; kc < nchunk; ++kc) {
        __syncthreads();
        for (int i = tid; i < 4096; i += 512) { const int mp = i >> 11, key = (i >> 6) & 31, c = i & 63; Ks[i] = ldf<T>(proj, (rowbase + kc * 32 + key) * INC + C_K + h * 128 + mp * 64 + c); }
        for (int i = tid; i < 4096; i += 512) { const int key = i >> 7, c = i & 127; Vs[i] = ldf<T>(proj, (rowbase + kc * 32 + key) * INC + C_V + h * 128 + c); }
        __syncthreads();
#pragma unroll 1
        for (int j = 0; j < 32; ++j) {
            const int key = kc * 32 + j, dist = t - key;
            if (dist < 0) continue;
            const float4* kp = (const float4*)(Ks + map * 2048 + j * 64);
            float a = 0.f;
#pragma unroll
            for (int i = 0; i < 16; ++i) { const float4 kv = kp[i]; a += q[4 * i] * kv.x + q[4 * i + 1] * kv.y + q[4 * i + 2] * kv.z + q[4 * i + 3] * kv.w; }
            const float sc = a * 0.125f + rel_bias[rel_bucket(dist) * NH + h];
            const float mnew = fmaxf(mrun, sc);
            const float alpha = __expf(mrun - mnew), p = __expf(sc - mnew);
            lrun = lrun * alpha + p;
            const float4* vp = (const float4*)(Vs + j * 128 + quarter * 32);
#pragma unroll
            for (int i = 0; i < 8; ++i) { const float4 vv = vp[i]; o[4 * i] = o[4 * i] * alpha + p * vv.x; o[4 * i + 1] = o[4 * i + 1] * alpha + p * vv.y; o[4 * i + 2] = o[4 * i + 2] * alpha + p * vv.z; o[4 * i + 3] = o[4 * i + 3] * alpha + p * vv.w; }
            mrun = mnew;
        }
    }
    const float inv = 1.0f / lrun;
#pragma unroll
    for (int i = 0; i < 32; ++i) o[i] *= inv;
    __syncthreads();
    float* Cs = sm;
    if (map == 1) {
#pragma unroll
        for (int i = 0; i < 32; ++i) Cs[ql * 128 + quarter * 32 + i] = o[i];
    }
    __syncthreads();
    if (map == 0) {
        const float lam = lam_s; float sq = 0.f;
#pragma unroll
        for (int i = 0; i < 32; ++i) { o[i] -= lam * Cs[ql * 128 + quarter * 32 + i]; sq += o[i] * o[i]; }
        ss[quarter][ql] = sq;
    }
    __syncthreads();
    if (map == 0) {
        const float tot = ss[0][ql] + ss[1][ql] + ss[2][ql] + ss[3][ql];
        const float rn = 1.0f / sqrtf(tot * (1.0f / 128.0f) + 1e-5f) * (1.0f - lam_init);
        float* op = mixed + (rowbase + t) * DM + h * 128 + quarter * 32;
#pragma unroll
        for (int i = 0; i < 32; ++i) op[i] = o[i] * rn * subln_g[quarter * 32 + i];
    }
}
template <class T>
__global__ void __launch_bounds__(256) k_pooled(const T* __restrict__ proj, float* __restrict__ pooled) {
    const size_t idx = (size_t)blockIdx.x * 256 + threadIdx.x;
    const int ch = (int)(idx & 255); const size_t row = idx >> 8;
    const int t = (int)(row % SEQ), g = ch >> 6, w = 2 << g;
    float s = 0.f;
    for (int i = 0; i < w; ++i) if (t - i >= 0) s += ldf<T>(proj, (row - i) * INC + C_P + ch);
    const float denom = (float)((t + 1) < w ? (t + 1) : w);
    pooled[row * 256 + ch] = s / denom - ldf<T>(proj, row * INC + C_P + ch);
}
__global__ void __launch_bounds__(256) k_poolmix(const float* __restrict__ pooled, const float* __restrict__ w_pool, const float* __restrict__ pool_scale, float* __restrict__ mixed) {
    const size_t idx = (size_t)blockIdx.x * 256 + threadIdx.x;
    const int ch = (int)(idx & 255); const size_t row = idx >> 8;
    const int g = ch >> 6, d = ch & 63;
    float a = 0.f;
    for (int c = 0; c < 64; ++c) a += pooled[row * 256 + g * 64 + c] * w_pool[(g * 64 + c) * 64 + d];
    mixed[row * DM + 512 + ch] = a * pool_scale[ch];
}
template <class T>
__global__ void __launch_bounds__(256) k_conv(const T* __restrict__ proj, const float* __restrict__ conv_w, float* __restrict__ mixed) {
    const size_t idx = (size_t)blockIdx.x * 256 + threadIdx.x;
    const int ch = (int)(idx & 255); const size_t row = idx >> 8;
    const int t = (int)(row % SEQ);
    float y = 0.f;
#pragma unroll
    for (int k = 0; k < 3; ++k) { const int back = 2 - k; if (t - back >= 0) { const size_t r2 = row - back; y += conv_w[k * 256 + ch] * (ldf<T>(proj, r2 * INC + C_GC + ch) * ldf<T>(proj, r2 * INC + C_HIN + ch)); } }
    mixed[row * DM + 768 + ch] = ldf<T>(proj, row * INC + C_GB + ch) * y;
}
}
#endif

extern "C" void kernel_launch(void* const* d_in, const int* in_sizes, int n_in, void* d_out, int out_size, void* d_ws, size_t ws_size, hipStream_t stream) {
    static int grid = 0;
    if (grid == 0) {
        int dev = 0, cus = 0, per_cu = 0;
        if (hipGetDevice(&dev) != hipSuccess || hipDeviceGetAttribute(&cus, hipDeviceAttributeMultiprocessorCount, dev) != hipSuccess) { fprintf(stderr, "kernel_launch: device query failed\n"); grid = -1; return; }
        if (hipFuncSetAttribute((const void*)mega_fwd, hipFuncAttributeMaxDynamicSharedMemorySize, LDS_BYTES) != hipSuccess) { fprintf(stderr, "kernel_launch: hipFuncSetAttribute failed\n"); grid = -1; return; }
        if (hipOccupancyMaxActiveBlocksPerMultiprocessor(&per_cu, (const void*)mega_fwd, NWAVES * 64, LDS_BYTES) != hipSuccess || per_cu < 1) { fprintf(stderr, "kernel_launch: occupancy query says %d blocks per CU\n", per_cu); per_cu = 1; }
        (void)hipGetLastError();
        grid = cus * (per_cu < 1 ? 1 : 1);
        if (ws_size < WS_END) { fprintf(stderr, "kernel_launch: workspace too small\n"); grid = -1; return; }
    }
    if (grid < 0) return;
    Args a{};
    for (int i = 0; i < 18; ++i) a.in[i] = (const float*)d_in[i];
    a.out = (float*)d_out; a.ws = (unsigned char*)d_ws;
#if PREFIX == 99
#if ONE_LAUNCH
    a.ph_lo = 0; a.ph_hi = NPHASE; a.use_sync = 1;
    if (hipMemsetAsync((char*)d_ws + WS_CTL, 0, CTL_ZERO_BYTES, stream) != hipSuccess) { fprintf(stderr, "kernel_launch: memset of the barrier words failed\n"); return; }
#if COOP_LAUNCH
    void* kargs[] = {&a};
    hipError_t e = hipLaunchCooperativeKernel((const void*)mega_fwd, dim3(grid), dim3(NWAVES * 64), kargs, LDS_BYTES, stream);
    if (e != hipSuccess) fprintf(stderr, "cooperative launch failed: %s (grid %d)\n", hipGetErrorString(e), grid);
#else
    hipLaunchKernelGGL(mega_fwd, dim3(grid), dim3(NWAVES * 64), LDS_BYTES, stream, a);
#endif
#else
#ifndef DUPMASK
#define DUPMASK 0
#endif
#ifndef DUPFLAGS
#define DUPFLAGS 0
#endif
    for (int ph = 0; ph < NPHASE; ++ph) { a.ph_lo = ph; a.ph_hi = ph + 1; a.use_sync = 0; hipLaunchKernelGGL(mega_fwd, dim3(grid), dim3(NWAVES * 64), LDS_BYTES, stream, a);
        if ((DUPMASK >> ph) & 1) { a.use_sync = DUPFLAGS; hipLaunchKernelGGL(mega_fwd, dim3(grid), dim3(NWAVES * 64), LDS_BYTES, stream, a); } }
#endif
#else
    const float* x = (const float*)d_in[0]; const float* g_mix = (const float*)d_in[1]; const float* w_in = (const float*)d_in[2];
    const float* lq1 = (const float*)d_in[3]; const float* lk1 = (const float*)d_in[4]; const float* lq2 = (const float*)d_in[5]; const float* lk2 = (const float*)d_in[6];
    const float* subln_g = (const float*)d_in[7]; const float* rel_bias = (const float*)d_in[8]; const float* w_pool = (const float*)d_in[9]; const float* pool_scale = (const float*)d_in[10];
    const float* conv_w = (const float*)d_in[11]; const float* w_o = (const float*)d_in[12]; const float* g_ffn = (const float*)d_in[13]; const float* w_gate = (const float*)d_in[14];
    const float* w_up = (const float*)d_in[15]; const float* w_down = (const float*)d_in[16]; const float* g_final = (const float*)d_in[17];
    float* X = (float*)d_out; char* ws = (char*)d_ws;
    if (ws_size < 500 * MiB) { fprintf(stderr, "workspace too small for the test build\n"); return; }
    float* R1 = (float*)ws; float* R0 = (float*)(ws + 340 * MiB); float* PL = (float*)(ws + 468 * MiB);
    const unsigned short* PROJb = (const unsigned short*)(ws + WS_PROJ); const unsigned short* MIXb = (const unsigned short*)(ws + WS_MIX); const unsigned short* HBb = (const unsigned short*)(ws + WS_H);
    for (int ph = 0; ph <= PREFIX; ++ph) { a.ph_lo = ph; a.ph_hi = ph + 1; a.use_sync = 0; hipLaunchKernelGGL(mega_fwd, dim3(grid), dim3(NWAVES * 64), LDS_BYTES, stream, a); }
    if (PREFIX < 3) (void)hipMemcpyAsync(X, x, (size_t)M * DM * 4, hipMemcpyDeviceToDevice, stream);
    for (int l = 0; l < DEPTH; ++l) {
        const float lam_init = 0.8f - 0.6f * expf(-0.3f * (float)l);
        const int done = (l == 0) ? PREFIX : 0;
        if (done < 1) {
            ref::k_rmsnorm<<<M / 4, 256, 0, stream>>>(X, g_mix + l * DM, R0, 1e-6f);
            ref::k_gemm32<0, float><<<dim3(INC / 64, M / 128), 256, 0, stream>>>(R0, DM, w_in + (size_t)l * DM * INC, nullptr, INC, R1, INC, DM);
        }
        if (done < 2) {
            if (done == 1) {
                ref::k_attn_naive<unsigned short><<<dim3(SEQ / 64, NH, BATCH), 512, 0, stream>>>(PROJb, 1.0f / QSCALE, rel_bias, lq1 + l * 64, lk1 + l * 64, lq2 + l * 64, lk2 + l * 64, subln_g + l * 128, lam_init, R0);
                ref::k_pooled<unsigned short><<<M, 256, 0, stream>>>(PROJb, PL);
                ref::k_conv<unsigned short><<<M, 256, 0, stream>>>(PROJb, conv_w + l * 3 * 256, R0);
            } else {
                ref::k_attn_naive<float><<<dim3(SEQ / 64, NH, BATCH), 512, 0, stream>>>(R1, 1.0f, rel_bias, lq1 + l * 64, lk1 + l * 64, lq2 + l * 64, lk2 + l * 64, subln_g + l * 128, lam_init, R0);
                ref::k_pooled<float><<<M, 256, 0, stream>>>(R1, PL);
                ref::k_conv<float><<<M, 256, 0, stream>>>(R1, conv_w + l * 3 * 256, R0);
            }
            ref::k_poolmix<<<M, 256, 0, stream>>>(PL, w_pool + (size_t)l * 4 * 64 * 64, pool_scale + l * 256, R0);
        }
        if (done < 3) {
            if (done == 2) ref::k_gemm32<1, unsigned short><<<dim3(DM / 64, M / 128), 256, 0, stream>>>(MIXb, DM, w_o + (size_t)l * DM * DM, nullptr, DM, X, DM, DM);
            else ref::k_gemm32<1, float><<<dim3(DM / 64, M / 128), 256, 0, stream>>>(R0, DM, w_o + (size_t)l * DM * DM, nullptr, DM, X, DM, DM);
        }
        if (done < 4) {
            ref::k_rmsnorm<<<M / 4, 256, 0, stream>>>(X, g_ffn + l * DM, R0, 1e-6f);
            for (int half = 0; half < 2; ++half) {
                const size_t r0 = (size_t)half * (M / 2);
                ref::k_gemm32<2, float><<<dim3(DFF / 32, M / 2 / 128), 256, 0, stream>>>(R0 + r0 * DM, DM, w_gate + (size_t)l * DM * DFF, w_up + (size_t)l * DM * DFF, DFF, R1, DFF, DM);
                ref::k_gemm32<1, float><<<dim3(DM / 64, M / 2 / 128), 256, 0, stream>>>(R1, DFF, w_down + (size_t)l * DFF * DM, nullptr, DM, X + r0 * DM, DM, DFF);
            }
        } else if (done < 5) {
            ref::k_gemm32<1, unsigned short><<<dim3(DM / 64, M / 128), 256, 0, stream>>>(HBb, DFF, w_down + (size_t)l * DFF * DM, nullptr, DM, X, DM, DFF);
        }
    }
    ref::k_rmsnorm<<<M / 4, 256, 0, stream>>>(X, g_final, X, 1e-6f);
#endif
}
```

```cpp
#include <hip/hip_runtime.h>
#include <cstdint>
#include <cstdio>
#include <cmath>

constexpr int BATCH = 8, SEQ = 4096, DM = 1024, M = BATCH * SEQ, DEPTH = 2;
constexpr int NH = 4, INC = 2560, DFF = 2816, NGU = 2 * DFF;
constexpr int C_Q = 0, C_K = 512, C_V = 1024, C_P = 1536, C_GB = 1792, C_GC = 2048, C_HIN = 2304;
constexpr float LOG2E = 1.4426950408889634f;
constexpr float QSCALE = 0.125f * LOG2E;
constexpr float RMS_EPS = 1e-6f, SUBLN_EPS = 1e-5f;
constexpr int NSSQ = 16;

__device__ __forceinline__ int rel_bucket(int n) {
    if (n < 16) return n;
    int b = 16;
    b += (n >= 19); b += (n >= 21); b += (n >= 24); b += (n >= 27); b += (n >= 31); b += (n >= 35); b += (n >= 40); b += (n >= 46);
    b += (n >= 52); b += (n >= 59); b += (n >= 67); b += (n >= 77); b += (n >= 87); b += (n >= 99); b += (n >= 113);
    return b;
}
namespace pg8 {
#define PG8_LAS __attribute__((address_space(3)))
typedef unsigned short bf16_t;
typedef short bf16x8 __attribute__((ext_vector_type(8)));
typedef float f32x4 __attribute__((ext_vector_type(4)));
typedef unsigned u32x4 __attribute__((ext_vector_type(4)));
constexpr int BM = 256, BK = 64, HALF = 128, HTB = HALF * BK * 2  , STAGE_BYTES = 8 * HTB, NXCD = 8, WGM = 8;

__host__ __device__ __forceinline__ int lds_byte(int r, int c) { const int st = (r >> 4) * 2 + (c >> 5), rr = r & 15, cc = c & 31, ob = rr * 64 + cc * 2; return st * 1024 + (ob ^ (((ob >> 9) & 1) << 5)); }
__host__ __device__ __forceinline__ void stage_rc(int b, int& R, int& C) { const int st = b / 1024, sb = b % 1024, swz = sb ^ (((sb >> 9) & 1) << 5); R = (st >> 1) * 16 + swz / 64; C = (st & 1) * 32 + (swz % 64) / 2; }
__host__ __device__ __forceinline__ int perm32(int rho) { const int n = rho >> 4, i = rho & 15; return 8 * (i >> 2) + 4 * n + (i & 3); }

struct Unit { int pm, pn; };
struct Gemm { const bf16_t* A; const bf16_t* Bt; int M, N, K; };

struct StaticOrder {
    int nM, nN, nwg, G, c;
    __host__ __device__ void init(int M, int N, int G_, int c_) { nM = M / BM; nN = N / BM; nwg = nM * nN; G = G_; c = c_; }
    __host__ __device__ bool next(int i, Unit& u) const {
        const long L = (long)i * G + c; if (L >= nwg) return false;
        int wgid = (int)L; { const int q = nwg / NXCD, r = nwg % NXCD, xcd = wgid % NXCD, off = wgid / NXCD; wgid = (xcd < r ? xcd * (q + 1) : r * (q + 1) + (xcd - r) * q) + off; }
        const int nig = WGM * nN, gid = wgid / nig, fm = gid * WGM, gsz = (nM - fm) < WGM ? (nM - fm) : WGM;
        u.pm = fm + ((wgid % nig) % gsz); u.pn = (wgid % nig) / gsz; return true;
    }
    __device__ __forceinline__ void a_ready(const Unit&) const {}
    __device__ __forceinline__ void done(const Unit&) const {}
};

typedef float f32x2 __attribute__((ext_vector_type(2)));
typedef unsigned u32x2 __attribute__((ext_vector_type(2)));
__device__ __forceinline__ unsigned cvt_pk_bf16(float lo, float hi) { typedef __bf16 bf2 __attribute__((ext_vector_type(2))); f32x2 v = {lo, hi}; bf2 b = __builtin_convertvector(v, bf2); return __builtin_bit_cast(unsigned, b); }
#ifndef WT_STORES
#define WT_STORES 1
#endif
__device__ __forceinline__ void st16(void* p, u32x4 v) {
#if WT_STORES
    asm volatile("global_store_dwordx4 %0, %1, off sc1\n\ts_nop 1" :: "v"(p), "v"(v) : "memory");
#else
    *(u32x4*)p = v;
#endif
}
__device__ __forceinline__ float row_rstd(const float* ssq, int row) {
    const f32x4 a = *(const f32x4*)(ssq + (size_t)row * 4);
    return 1.0f / sqrtf(((a[0] + a[1]) + (a[2] + a[3])) * (1.0f / 1024.0f) + 1e-6f);
}
struct EpiProj {
    static constexpr bool PERM = true, AFTER_DRAIN = false;
    bf16_t* O; bf16_t* KT; bf16_t* VT; const PG8_LAS float* rtab; int ldc; float qscale; int skip;
    __device__ __forceinline__ void operator()(const f32x4 (&acc)[2][2][4][2], const Unit& u, int ui, int wr, int wc, int fr, int fq) const {
        if (skip & 8) { _Pragma("unroll") for (int a_ = 0; a_ < 2; ++a_) _Pragma("unroll") for (int b_ = 0; b_ < 2; ++b_) _Pragma("unroll") for (int m_ = 0; m_ < 4; ++m_) _Pragma("unroll") for (int n_ = 0; n_ < 2; ++n_) asm volatile("" :: "v"(acc[a_][b_][m_][n_])); return; }
        const float cs = (u.pn < 2) ? qscale : 1.0f;
#pragma unroll
        for (int ai = 0; ai < 2; ++ai)
#pragma unroll
            for (int m = 0; m < 4; ++m) {
                const int row = u.pm * BM + ai * HALF + wr * 64 + m * 16 + fr;
                const float rs = rtab[ui * 256 + ai * HALF + wr * 64 + m * 16 + fr] * cs;
                bf16_t* rowp = O + (size_t)row * ldc + u.pn * BM + wc * 32 + 8 * fq;
                const int bb = row >> 12, tt = (row >> 6) & 63, kk = row & 63;
#pragma unroll
                for (int bj = 0; bj < 2; ++bj) { const f32x4 v0 = acc[ai][bj][m][0] * rs, v1 = acc[ai][bj][m][1] * rs;
                    u32x4 w; w.x = cvt_pk_bf16(v0[0], v0[1]); w.y = cvt_pk_bf16(v0[2], v0[3]); w.z = cvt_pk_bf16(v1[0], v1[1]); w.w = cvt_pk_bf16(v1[2], v1[3]);
                    bf16_t* dst = rowp + bj * HALF;
                    if (u.pn >= 2 && u.pn < 6) {
                        const int c0 = (u.pn & 1) * BM + bj * HALF + wc * 32 + 8 * fq;
                        const size_t img = ((size_t)(bb * 4 + (c0 >> 7)) * 64 + tt) * 8192;
                        if (u.pn < 4) dst = KT + img + (((c0 >> 6) & 1) * 8 + ((c0 & 63) >> 3)) * 512 + kk * 8;
                        else dst = VT + img + ((c0 & 127) >> 5) * 2048 + (kk >> 4) * 512 + (kk & 15) * 32 + (c0 & 31);
                    }
                    if (skip & 32) asm volatile("" :: "v"(w)); else st16(dst, w); }
            }
    }
};
struct EpiSwiGLU {
    static constexpr bool PERM = true, AFTER_DRAIN = false;
    bf16_t* O; const PG8_LAS float* rtab; int ldc; int skip;
    __device__ __forceinline__ void operator()(const f32x4 (&acc)[2][2][4][2], const Unit& u, int ui, int wr, int wc, int fr, int fq) const {
        if (skip) { _Pragma("unroll") for (int a_ = 0; a_ < 2; ++a_) _Pragma("unroll") for (int b_ = 0; b_ < 2; ++b_) _Pragma("unroll") for (int m_ = 0; m_ < 4; ++m_) _Pragma("unroll") for (int n_ = 0; n_ < 2; ++n_) asm volatile("" :: "v"(acc[a_][b_][m_][n_])); return; }
#pragma unroll
        for (int ai = 0; ai < 2; ++ai)
#pragma unroll
            for (int m = 0; m < 4; ++m) {
                const int row = u.pm * BM + ai * HALF + wr * 64 + m * 16 + fr;
                const float rs = rtab[ui * 256 + ai * HALF + wr * 64 + m * 16 + fr];
                float hv[8];
#pragma unroll
                for (int n = 0; n < 2; ++n)
#pragma unroll
                    for (int e = 0; e < 4; ++e) { const float g = acc[ai][0][m][n][e] * rs, uu = acc[ai][1][m][n][e] * rs;
                        hv[4 * n + e] = g * __builtin_amdgcn_rcpf(1.0f + __builtin_amdgcn_exp2f(-g * 1.4426950408889634f)) * uu; }
                u32x4 w; w.x = cvt_pk_bf16(hv[0], hv[1]); w.y = cvt_pk_bf16(hv[2], hv[3]); w.z = cvt_pk_bf16(hv[4], hv[5]); w.w = cvt_pk_bf16(hv[6], hv[7]);
                st16(O + (size_t)row * ldc + u.pn * HALF + wc * 32 + 8 * fq, w);
            }
    }
};
struct EpiRes {
    static constexpr bool PERM = true, AFTER_DRAIN = false;
    bf16_t* xb; float* ssq; PG8_LAS float* red;
    __device__ __forceinline__ void operator()(const f32x4 (&acc)[2][2][4][2], const Unit& u, int ui, int wr, int wc, int fr, int fq) const {
        u32x4 bs[2][4][2];
#pragma unroll
        for (int ai = 0; ai < 2; ++ai)
#pragma unroll
            for (int m = 0; m < 4; ++m) {
                const bf16_t* rowp = xb + (size_t)(u.pm * BM + ai * HALF + wr * 64 + m * 16 + fr) * 1024 + u.pn * BM + wc * 32 + 8 * fq;
#pragma unroll
                for (int bj = 0; bj < 2; ++bj) bs[ai][m][bj] = *(const u32x4*)(rowp + bj * HALF);
            }
#pragma unroll
        for (int ai = 0; ai < 2; ++ai)
#pragma unroll
            for (int m = 0; m < 4; ++m) {
                const int rl = ai * HALF + wr * 64 + m * 16 + fr, row = u.pm * BM + rl;
                bf16_t* rowp = xb + (size_t)row * 1024 + u.pn * BM + wc * 32 + 8 * fq;
                float sq = 0.f;
#pragma unroll
                for (int bj = 0; bj < 2; ++bj) {
                    const u32x4 b = bs[ai][m][bj];
                    f32x4 v0 = acc[ai][bj][m][0], v1 = acc[ai][bj][m][1];
                    v0[0] += __builtin_bit_cast(float, b.x << 16); v0[1] += __builtin_bit_cast(float, b.x & 0xffff0000u);
                    v0[2] += __builtin_bit_cast(float, b.y << 16); v0[3] += __builtin_bit_cast(float, b.y & 0xffff0000u);
                    v1[0] += __builtin_bit_cast(float, b.z << 16); v1[1] += __builtin_bit_cast(float, b.z & 0xffff0000u);
                    v1[2] += __builtin_bit_cast(float, b.w << 16); v1[3] += __builtin_bit_cast(float, b.w & 0xffff0000u);
                    sq += ((v0[0] * v0[0] + v0[1] * v0[1]) + (v0[2] * v0[2] + v0[3] * v0[3])) + ((v1[0] * v1[0] + v1[1] * v1[1]) + (v1[2] * v1[2] + v1[3] * v1[3]));
                    u32x4 w; w.x = cvt_pk_bf16(v0[0], v0[1]); w.y = cvt_pk_bf16(v0[2], v0[3]); w.z = cvt_pk_bf16(v1[0], v1[1]); w.w = cvt_pk_bf16(v1[2], v1[3]);
                    st16(rowp + bj * HALF, w);
                }
                sq += __shfl_xor(sq, 16); sq += __shfl_xor(sq, 32);
                if (fq == 0) red[rl * 4 + wc] = sq;
            }
        asm volatile("s_waitcnt lgkmcnt(0)\n\ts_barrier" ::: "memory");
        const int tid = (wr * 4 + wc) * 64 + fq * 16 + fr;
        if (tid < 256) { const f32x4 p = *(const PG8_LAS f32x4*)(red + tid * 4); ssq[(size_t)(u.pm * BM + tid) * 4 + u.pn] = (p[0] + p[1]) + (p[2] + p[3]); }
    }
};

struct EpiResFinal {
    static constexpr bool PERM = true, AFTER_DRAIN = false;
    const bf16_t* xb; float* ssq; float* out; const float* gfin; unsigned* cnt; PG8_LAS float* red;
    __device__ __forceinline__ void operator()(const f32x4 (&acc_)[2][2][4][2], const Unit& u, int ui, int wr, int wc, int fr, int fq) const {
        f32x4 (&acc)[2][2][4][2] = const_cast<f32x4 (&)[2][2][4][2]>(acc_);
        const int tid = (wr * 4 + wc) * 64 + fq * 16 + fr;
        u32x4 bs[2][4][2];
#pragma unroll
        for (int ai = 0; ai < 2; ++ai)
#pragma unroll
            for (int m = 0; m < 4; ++m) {
                const bf16_t* rowp = xb + (size_t)(u.pm * BM + ai * HALF + wr * 64 + m * 16 + fr) * 1024 + u.pn * BM + wc * 32 + 8 * fq;
#pragma unroll
                for (int bj = 0; bj < 2; ++bj) bs[ai][m][bj] = *(const u32x4*)(rowp + bj * HALF);
            }
#pragma unroll
        for (int ai = 0; ai < 2; ++ai)
#pragma unroll
            for (int m = 0; m < 4; ++m) {
                const int rl = ai * HALF + wr * 64 + m * 16 + fr, row = u.pm * BM + rl;
                float sq = 0.f;
#pragma unroll
                for (int bj = 0; bj < 2; ++bj) {
                    const u32x4 b = bs[ai][m][bj];
                    f32x4 v0 = acc[ai][bj][m][0], v1 = acc[ai][bj][m][1];
                    v0[0] += __builtin_bit_cast(float, b.x << 16); v0[1] += __builtin_bit_cast(float, b.x & 0xffff0000u);
                    v0[2] += __builtin_bit_cast(float, b.y << 16); v0[3] += __builtin_bit_cast(float, b.y & 0xffff0000u);
                    v1[0] += __builtin_bit_cast(float, b.z << 16); v1[1] += __builtin_bit_cast(float, b.z & 0xffff0000u);
                    v1[2] += __builtin_bit_cast(float, b.w << 16); v1[3] += __builtin_bit_cast(float, b.w & 0xffff0000u);
                    sq += ((v0[0] * v0[0] + v0[1] * v0[1]) + (v0[2] * v0[2] + v0[3] * v0[3])) + ((v1[0] * v1[0] + v1[1] * v1[1]) + (v1[2] * v1[2] + v1[3] * v1[3]));
                    acc[ai][bj][m][0] = v0; acc[ai][bj][m][1] = v1;
                }
                sq += __shfl_xor(sq, 16); sq += __shfl_xor(sq, 32);
                if (fq == 0) red[rl * 4 + wc] = sq;
            }
        asm volatile("s_waitcnt lgkmcnt(0)\n\ts_barrier" ::: "memory");
        if (tid < 256) { const f32x4 p = *(const PG8_LAS f32x4*)(red + tid * 4);
            __hip_atomic_store(ssq + (size_t)(u.pm * BM + tid) * 4 + u.pn, (p[0] + p[1]) + (p[2] + p[3]), __ATOMIC_RELAXED, __HIP_MEMORY_SCOPE_AGENT); }
        asm volatile("s_waitcnt vmcnt(0)\n\ts_barrier" ::: "memory");
        unsigned* c = cnt + 64 * u.pm;
        if (tid == 0) __hip_atomic_fetch_add(c, 1u, __ATOMIC_RELAXED, __HIP_MEMORY_SCOPE_AGENT);
        if (tid < 64) {
            unsigned sp = 0u;
            while ((unsigned)__builtin_amdgcn_readfirstlane(__hip_atomic_load(c, __ATOMIC_RELAXED, __HIP_MEMORY_SCOPE_AGENT)) < 4u) { __builtin_amdgcn_s_sleep(2); if (++sp > (1u << 22)) break; }
            __builtin_amdgcn_fence(__ATOMIC_ACQUIRE, "agent");
        }
        asm volatile("s_waitcnt vmcnt(0) lgkmcnt(0)\n\ts_barrier" ::: "memory");
        PG8_LAS float* rs = red + 1024;
        if (tid < 256) { const float* sp4 = ssq + (size_t)(u.pm * BM + tid) * 4; float s = 0.f;
#pragma unroll
            for (int t = 0; t < 4; ++t) s += __hip_atomic_load(sp4 + t, __ATOMIC_RELAXED, __HIP_MEMORY_SCOPE_AGENT);
            rs[tid] = 1.0f / sqrtf(s * (1.0f / 1024.0f) + 1e-6f); }
        asm volatile("s_waitcnt vmcnt(0) lgkmcnt(0)\n\ts_barrier" ::: "memory");
        f32x4 g[2][2];
#pragma unroll
        for (int bj = 0; bj < 2; ++bj)
#pragma unroll
            for (int n = 0; n < 2; ++n) g[bj][n] = *(const f32x4*)(gfin + u.pn * BM + bj * HALF + wc * 32 + 8 * fq + 4 * n);
#pragma unroll
        for (int ai = 0; ai < 2; ++ai)
#pragma unroll
            for (int m = 0; m < 4; ++m) {
                const int rl = ai * HALF + wr * 64 + m * 16 + fr, row = u.pm * BM + rl;
                const float r = rs[rl];
                float* op = out + (size_t)row * 1024 + u.pn * BM + wc * 32 + 8 * fq;
#pragma unroll
                for (int bj = 0; bj < 2; ++bj)
#pragma unroll
                    for (int n = 0; n < 2; ++n) *(f32x4*)(op + bj * HALF + 4 * n) = acc[ai][bj][m][n] * r * g[bj][n];
            }
    }
};
template <class Epi, class Sched, bool ALIGN_EPI = false, bool SP2 = false>
__device__ __forceinline__ void gemm_phase(PG8_LAS unsigned char* lds, const Gemm g, const Sched& S, const Epi& E) {
    int tid_ = threadIdx.x; asm volatile("" : "+v"(tid_));
    const int tid = tid_, wid = __builtin_amdgcn_readfirstlane(tid >> 6), lane = tid & 63, wr = wid >> 2, wc = wid & 3, fr = lane & 15, fq = lane >> 4;
    const int K = g.K, nt = K / BK;
    unsigned voffA[2], voffB[2];
#pragma unroll
    for (int i = 0; i < 2; ++i) { int R, C; stage_rc(tid * 16 + i * 8192, R, C); const int Rb = Epi::PERM ? ((R & ~31) + perm32(R & 31)) : R;
        voffA[i] = (unsigned)(R * K + C) * 2u; voffB[i] = (unsigned)(Rb * K + C) * 2u; }
    const size_t kstep = (size_t)(BK * 2);
    const size_t hstep = (size_t)HALF * K * 2;
    const size_t tstep = 2 * hstep;
    const unsigned ldsw = (unsigned)wid * 1024u;
    const int aoff = lds_byte(wr * 64 + fr, fq * 8), boff = lds_byte(wc * 32 + fr, fq * 8);
#define PG8_SA(b, h) (((b) * 2 + (h)) * HTB)
#define PG8_SB(b, h) ((4 + (b) * 2 + (h)) * HTB)
#define PG8_STAGE(bufoff, gbase, voff) do { _Pragma("unroll") for (int _i = 0; _i < 2; ++_i) \
        __builtin_amdgcn_global_load_lds((const unsigned*)((const char*)(gbase) + (voff)[_i]), (PG8_LAS unsigned*)(lds + (bufoff) + ldsw + _i * 8192), 16, 0, 0); } while (0)
#define PG8_LDA(dst, b, h) do { _Pragma("unroll") for (int m = 0; m < 4; ++m) _Pragma("unroll") for (int k = 0; k < 2; ++k) dst[m][k] = *(const PG8_LAS bf16x8*)(lds + PG8_SA(b, h) + aoff + m * 2048 + k * 1024); } while (0)
#define PG8_LDB(dst, b, h) do { _Pragma("unroll") for (int n = 0; n < 2; ++n) _Pragma("unroll") for (int k = 0; k < 2; ++k) dst[n][k] = *(const PG8_LAS bf16x8*)(lds + PG8_SB(b, h) + boff + n * 2048 + k * 1024); } while (0)
#define PG8_MMA(ai, bj, At, Bt) do { __builtin_amdgcn_s_setprio(1); _Pragma("unroll") for (int m = 0; m < 4; ++m) _Pragma("unroll") for (int n = 0; n < 2; ++n) _Pragma("unroll") for (int k = 0; k < 2; ++k) \
        acc[ai][bj][m][n] = __builtin_amdgcn_mfma_f32_16x16x32_bf16(Bt[n][k], At[m][k], acc[ai][bj][m][n], 0, 0, 0); __builtin_amdgcn_s_setprio(0); } while (0)
#define PG8_WAIT_V(n) asm volatile("s_waitcnt vmcnt(" #n ")" ::: "memory")
#define PG8_WAIT_L(n) asm volatile("s_waitcnt lgkmcnt(" #n ")" ::: "memory")
#define PG8_BAR __builtin_amdgcn_s_barrier()
#define PG8_SCHED __builtin_amdgcn_sched_barrier(0)
    Unit cur, nxt; int ui = 0;
    if (!S.next(0, cur)) return;
    f32x4 acc[2][2][4][2];
#pragma unroll
    for (int a = 0; a < 2; ++a)
#pragma unroll
        for (int b = 0; b < 2; ++b)
#pragma unroll
            for (int m = 0; m < 4; ++m)
#pragma unroll
                for (int n = 0; n < 2; ++n) acc[a][b][m][n] = (f32x4){0.f, 0.f, 0.f, 0.f};
    bf16x8 At[4][2], B0[2][2], B1[2][2];
    const char* cA = (const char*)g.A + (size_t)cur.pm * tstep; const char* cB = (const char*)g.Bt + (size_t)cur.pn * tstep;
    S.a_ready(cur);
    if constexpr (SP2) {
        PG8_STAGE(PG8_SB(0, 0), cB, voffB); PG8_STAGE(PG8_SB(0, 1), cB + hstep, voffB); PG8_STAGE(PG8_SA(0, 0), cA, voffA); PG8_STAGE(PG8_SA(0, 1), cA + hstep, voffA);
        if (wr == 1) PG8_BAR;
        PG8_WAIT_V(2); PG8_BAR;
        PG8_STAGE(PG8_SB(1, 0), cB + kstep, voffB); PG8_STAGE(PG8_SA(1, 0), cA + kstep, voffA); PG8_STAGE(PG8_SB(1, 1), cB + hstep + kstep, voffB);
        PG8_WAIT_V(6); PG8_BAR;
    } else {
        PG8_STAGE(PG8_SB(0, 0), cB, voffB); PG8_STAGE(PG8_SA(0, 0), cA, voffA); PG8_STAGE(PG8_SB(0, 1), cB + hstep, voffB); PG8_STAGE(PG8_SA(0, 1), cA + hstep, voffA);
        if (wr == 1) PG8_BAR;
        PG8_WAIT_V(4); PG8_BAR;
        PG8_STAGE(PG8_SB(1, 0), cB + kstep, voffB); PG8_STAGE(PG8_SA(1, 0), cA + kstep, voffA); PG8_STAGE(PG8_SB(1, 1), cB + hstep + kstep, voffB);
        PG8_WAIT_V(6); PG8_BAR;
    }
    for (;;) {
        const bool has_next = S.next(ui + 1, nxt);
        const char* nA = has_next ? (const char*)g.A + (size_t)nxt.pm * tstep : cA; const char* nB = has_next ? (const char*)g.Bt + (size_t)nxt.pn * tstep : cB;
        for (int t = 0; t < nt; t += 2) {
            const bool last = (t == nt - 2);
            const char* a1 = cA + (size_t)(t + 1) * kstep;
            const char* a2 = last ? nA : cA + (size_t)(t + 2) * kstep; const char* b2 = last ? nB : cB + (size_t)(t + 2) * kstep;
            const char* a3 = a2 + kstep; const char* b3 = b2 + kstep;
            if (last && has_next) S.a_ready(nxt);
            if constexpr (SP2) {
            PG8_LDB(B0, 0, 0); PG8_LDB(B1, 0, 1); PG8_SCHED; PG8_LDA(At, 0, 0); PG8_STAGE(PG8_SA(1, 1), a1 + hstep, voffA);
            PG8_WAIT_V(8); PG8_WAIT_L(0); PG8_BAR; PG8_MMA(0, 0, At, B0); PG8_MMA(0, 1, At, B1); PG8_BAR; PG8_SCHED;
            PG8_LDA(At, 0, 1); PG8_STAGE(PG8_SB(0, 0), b2, voffB); PG8_STAGE(PG8_SB(0, 1), b2 + hstep, voffB); PG8_STAGE(PG8_SA(0, 0), a2, voffA);
            PG8_WAIT_V(8); PG8_WAIT_L(0); PG8_BAR; PG8_MMA(1, 0, At, B0); PG8_MMA(1, 1, At, B1); PG8_BAR; PG8_SCHED;
            PG8_LDB(B0, 1, 0); PG8_LDB(B1, 1, 1); PG8_SCHED; PG8_LDA(At, 1, 0); PG8_STAGE(PG8_SA(0, 1), a2 + hstep, voffA);
            PG8_WAIT_V(8); PG8_WAIT_L(0); PG8_BAR; PG8_MMA(0, 0, At, B0); PG8_MMA(0, 1, At, B1); PG8_BAR; PG8_SCHED;
            PG8_LDA(At, 1, 1); PG8_STAGE(PG8_SB(1, 0), b3, voffB); PG8_STAGE(PG8_SB(1, 1), b3 + hstep, voffB); PG8_STAGE(PG8_SA(1, 0), a3, voffA);
            PG8_WAIT_V(8); PG8_WAIT_L(0); PG8_BAR; PG8_MMA(1, 0, At, B0); PG8_MMA(1, 1, At, B1); PG8_BAR; PG8_SCHED;
            } else {
            PG8_LDB(B0, 0, 0); PG8_SCHED; PG8_LDA(At, 0, 0); PG8_STAGE(PG8_SA(1, 1), a1 + hstep, voffA);
            PG8_WAIT_L(8); PG8_BAR; PG8_WAIT_L(0); PG8_MMA(0, 0, At, B0); PG8_BAR; PG8_SCHED;
            PG8_LDB(B1, 0, 1); PG8_STAGE(PG8_SB(0, 0), b2, voffB);
            PG8_BAR; PG8_WAIT_L(0); PG8_MMA(0, 1, At, B1); PG8_BAR;
            PG8_LDA(At, 0, 1); PG8_STAGE(PG8_SA(0, 0), a2, voffA);
            PG8_BAR; PG8_WAIT_L(0); PG8_MMA(1, 0, At, B0); PG8_BAR; PG8_SCHED;
            PG8_STAGE(PG8_SB(0, 1), b2 + hstep, voffB);
            PG8_WAIT_V(6); PG8_BAR; PG8_MMA(1, 1, At, B1); PG8_BAR;
            PG8_LDB(B0, 1, 0); PG8_SCHED; PG8_LDA(At, 1, 0); PG8_STAGE(PG8_SA(0, 1), a2 + hstep, voffA);
            PG8_WAIT_L(8); PG8_BAR; PG8_WAIT_L(0); PG8_MMA(0, 0, At, B0); PG8_BAR; PG8_SCHED;
            PG8_LDB(B1, 1, 1); PG8_STAGE(PG8_SB(1, 0), b3, voffB);
            PG8_BAR; PG8_WAIT_L(0); PG8_MMA(0, 1, At, B1); PG8_BAR;
            PG8_LDA(At, 1, 1); PG8_STAGE(PG8_SA(1, 0), a3, voffA);
            PG8_BAR; PG8_WAIT_L(0); PG8_MMA(1, 0, At, B0); PG8_BAR; PG8_SCHED;
            PG8_STAGE(PG8_SB(1, 1), b3 + hstep, voffB);
            PG8_WAIT_V(6); PG8_BAR; PG8_MMA(1, 1, At, B1); PG8_BAR;
            }
        }
        if constexpr (ALIGN_EPI) { if (wr == 0) PG8_BAR; }
        if constexpr (!Epi::AFTER_DRAIN) { E(acc, cur, ui, wr, wc, fr, fq); S.done(cur); }
        if (!has_next) break;
#pragma unroll
        for (int a = 0; a < 2; ++a)
#pragma unroll
            for (int b = 0; b < 2; ++b)
#pragma unroll
                for (int m = 0; m < 4; ++m)
#pragma unroll
                    for (int n = 0; n < 2; ++n) acc[a][b][m][n] = (f32x4){0.f, 0.f, 0.f, 0.f};
        cur = nxt; cA = nA; cB = nB; ++ui;
        if constexpr (ALIGN_EPI) { if (wr == 1) PG8_BAR; }
    }
    PG8_WAIT_V(0);
    if constexpr (!ALIGN_EPI) { if (wr == 0) PG8_BAR; }
    PG8_BAR;
    if constexpr (Epi::AFTER_DRAIN) { E.fused(acc, cur, wr, wc, fr, fq, lds, wid, lane); S.done(cur); }
#undef PG8_SA
#undef PG8_SB
#undef PG8_STAGE
#undef PG8_LDA
#undef PG8_LDB
#undef PG8_MMA
#undef PG8_WAIT_V
#undef PG8_WAIT_L
#undef PG8_BAR
#undef PG8_SCHED
}
}

#ifndef PG8_SP2
#define PG8_SP2 true
#endif
#ifndef PG8_ALIGN
#define PG8_ALIGN true
#endif
namespace att3 {
using bf16x8 = __attribute__((ext_vector_type(8))) short;
using s16x4 = __attribute__((ext_vector_type(4))) short;
using f32x16 = __attribute__((ext_vector_type(16))) float;
using u32x4 = __attribute__((ext_vector_type(4))) unsigned;
typedef __attribute__((address_space(3))) char* lds_ptr;
typedef __attribute__((address_space(3))) const char* lds_cptr;
typedef short v4i16_t __attribute__((ext_vector_type(4)));
typedef __attribute__((address_space(3))) float* lds_fptr;
constexpr int KVBLK = 64, QROWS = 128, NSLOT = 3, SLOTB = 16384;
constexpr int LDS_K = 0, LDS_V = NSLOT * SLOTB, LDS_WS = 131072 + 1024, LDS_BT = LDS_WS + 8 * 256, LDS_CMB = 65536;
#define SBAR() __builtin_amdgcn_sched_barrier(0)
#define PIN(x) asm volatile("" : "+v"(x))
#define WAIT_BAR(N) asm volatile("s_waitcnt vmcnt(" #N ") lgkmcnt(0)\n\ts_barrier" ::: "memory")
#define MFMA(a, b, c) __builtin_amdgcn_mfma_f32_32x32x16_bf16(a, b, c, 0, 0, 0)
#define MX3(a, b, c) __builtin_fmaxf(__builtin_fmaxf((a), (b)), (c))
#define EX(v) __builtin_amdgcn_exp2f(v)
__device__ __forceinline__ int crow(int r, int hi) { return (r & 3) + 8 * (r >> 2) + 4 * hi; }
__device__ __forceinline__ void glds16(const void* gsrc, unsigned lds_dst) { unsigned keep;
    asm volatile("s_mov_b32 %0, m0\n\ts_mov_b32 m0, %2\n\ts_nop 0\n\tglobal_load_lds_dwordx4 %1, off\n\ts_mov_b32 m0, %0" : "=&s"(keep) : "v"(gsrc), "s"(lds_dst) : "memory"); }
__device__ __forceinline__ s16x4 vtr(lds_cptr p) { return __builtin_bit_cast(s16x4, __builtin_amdgcn_ds_read_tr16_b64_v4i16((__attribute__((address_space(3))) v4i16_t*)p)); }
__device__ __forceinline__ unsigned cvtpk(float lo, float hi) { typedef float f2 __attribute__((ext_vector_type(2))); typedef __bf16 b2 __attribute__((ext_vector_type(2))); f2 v = {lo, hi}; b2 b = __builtin_convertvector(v, b2); return __builtin_bit_cast(unsigned, b); }
__device__ __forceinline__ void kload2(bf16x8* kf, lds_cptr kp, int j) { kf[2 * j] = *(const __attribute__((address_space(3))) bf16x8*)(kp + j * 2048); kf[2 * j + 1] = *(const __attribute__((address_space(3))) bf16x8*)(kp + j * 2048 + 512); }
__device__ __forceinline__ float half_sum(float m) { auto rr = __builtin_amdgcn_permlane32_swap(__float_as_uint(m), __float_as_uint(m), false, false); return __uint_as_float(rr[0]) + __uint_as_float(rr[1]); }

struct Params { const unsigned short* proj; const unsigned short* kt; const unsigned short* vt; unsigned short* mix; const float* rel_bias; const float* subln_g; float lam, lam_init; };

__device__ __forceinline__ void band(f32x16& p0, f32x16& p1, int kv0, int qpos, int hi, lds_fptr btab) {
    const int db = qpos - kv0 - 4 * hi;
    const lds_fptr bp = btab + (db + 128 - 59);
    f32x16 bb;
#pragma unroll
    for (int r = 0; r < 16; ++r) bb[r] = bp[59 - ((r & 3) + 8 * (r >> 2))];
    PIN(bb);
#pragma unroll
    for (int r = 0; r < 16; ++r) p0[r] = (db - ((r & 3) + 8 * (r >> 2))) < 0 ? -INFINITY : p0[r] + bb[r];
    PIN(p0);
#pragma unroll
    for (int r = 0; r < 16; ++r) bb[r] = bp[59 - ((r & 3) + 8 * (r >> 2)) - 32];
    PIN(bb);
#pragma unroll
    for (int r = 0; r < 16; ++r) p1[r] = (db - ((r & 3) + 8 * (r >> 2))) < 32 ? -INFINITY : p1[r] + bb[r];
}

template <int THRL>
__device__ __forceinline__ void attn_unit(int b, int h, int qb, bool pre, int nb, int nh, int nqb, const Params& P, lds_ptr lds) {
    int tid_ = threadIdx.x; asm volatile("" : "+v"(tid_));
    const int tid = tid_, lane = tid & 63, r32 = lane & 31, hi = lane >> 5; const int wid = __builtin_amdgcn_readfirstlane(tid >> 6);
    const int map = wid >> 2, rg = wid & 3;
    const size_t rowbase = (size_t)b * SEQ; const int q0 = qb * QROWS, qrow0 = q0 + rg * 32, qpos = qrow0 + r32;
    const int NT = (q0 + QROWS) / KVBLK;
    const unsigned lds0 = (unsigned)(uintptr_t)lds;
    const lds_fptr wsf = (lds_fptr)(lds + LDS_WS) + wid * 64;
    const lds_fptr btab = (lds_fptr)(lds + LDS_BT);
    if (tid < 384) { const int d = tid - 128; btab[tid] = d < 0 ? -INFINITY : (d < 128 ? (P.rel_bias[rel_bucket(d) * NH + h] - P.rel_bias[31 * NH + h]) * LOG2E : 0.f); }
    const unsigned short* ksrc = P.kt + (size_t)(b * NH + h) * 64 * 8192 + wid * 512 + lane * 8;
    const unsigned short* vsrc = P.vt + (size_t)(b * NH + h) * 64 * 8192 + wid * 512 + lane * 8;
    const unsigned kdst = lds0 + LDS_K + wid * 1024, vdst = lds0 + LDS_V + wid * 1024;
#define DMA_K(t, slot) do { const unsigned short* s_ = ksrc + (size_t)(t) * 8192; glds16(s_, (unsigned)__builtin_amdgcn_readfirstlane(kdst + (slot))); glds16(s_ + 4096, (unsigned)__builtin_amdgcn_readfirstlane(kdst + 8192 + (slot))); } while (0)
#define DMA_V(t, slot) do { const unsigned short* s_ = vsrc + (size_t)(t) * 8192; glds16(s_, (unsigned)__builtin_amdgcn_readfirstlane(vdst + (slot))); glds16(s_ + 4096, (unsigned)__builtin_amdgcn_readfirstlane(vdst + 8192 + (slot))); } while (0)
    const lds_cptr shm3 = (lds_cptr)lds;
    const lds_cptr kp0 = shm3 + LDS_K + map * 8192 + hi * 1024 + r32 * 16;
    const lds_cptr vp0 = shm3 + LDS_V + ((lane >> 4) & 1) * 32 + (lane & 3) * 8 + (4 * hi + ((lane & 15) >> 2)) * 64;
    if (!pre) { DMA_K(0, 0); DMA_V(0, 0); DMA_K(1, SLOTB); if (NT > 2) DMA_K(2, 2 * SLOTB); }
    bf16x8 qr[4];
    { const unsigned short* Qw = P.proj + (rowbase + qpos) * INC + C_Q + h * 128 + map * 64 + hi * 8;
#pragma unroll
      for (int d0 = 0; d0 < 4; ++d0) qr[d0] = *reinterpret_cast<const bf16x8*>(Qw + d0 * 16); }
    float mhat = 0.f, l_reg = 0.f;
    f32x16 o[4];
#pragma unroll
    for (int d = 0; d < 4; ++d)
#pragma unroll
        for (int r = 0; r < 16; ++r) o[d][r] = 0.f;
    f32x16 negm;
#pragma unroll
    for (int r = 0; r < 16; ++r) negm[r] = 0.f;
    asm volatile("" : "+v"(negm));
    bool resc = false;
#define BAND(P0, P1, t) do { if ((t) >= NT - 4) band(P0, P1, (t) * KVBLK, qpos, hi, btab); } while (0)
#define RESC() do { if (resc) { asm volatile("s_waitcnt lgkmcnt(0)" ::: "memory"); \
      _Pragma("unroll") for (int r = 0; r < 16; ++r) { const float f_ = wsf[crow(r, hi)]; _Pragma("unroll") for (int d_ = 0; d_ < 4; ++d_) o[d_][r] *= f_; } } } while (0)
    f32x16 pA0, pA1, pB0, pB1;
    bf16x8 kf[8];
    int sl_prev = 0, sl_cur = 0, sl_next = SLOTB;
#define ROT() do { sl_prev = sl_cur; sl_cur = sl_next; sl_next = (sl_next == (NSLOT - 1) * SLOTB) ? 0 : sl_next + SLOTB; } while (0)
    WAIT_BAR(0);
    {
        pA0 = negm; pA1 = negm;
#pragma unroll
        for (int j = 0; j < 4; ++j) kload2(kf, kp0, j);
        PIN(kf[0]); PIN(kf[2]); PIN(kf[4]); PIN(kf[6]);
#pragma unroll
        for (int d0 = 0; d0 < 4; ++d0) { pA0 = MFMA(kf[2 * d0], qr[d0], pA0); pA1 = MFMA(kf[2 * d0 + 1], qr[d0], pA1); }
        BAND(pA0, pA1, 0);
        float rm = MX3(pA0[0], pA0[1], pA1[0]);
#pragma unroll
        for (int r = 1; r < 16; ++r) rm = MX3(rm, pA0[r], pA1[r]);
        { auto rr = __builtin_amdgcn_permlane32_swap(__float_as_uint(rm), __float_as_uint(rm), false, false); rm = __builtin_fmaxf(__uint_as_float(rr[0]), __uint_as_float(rr[1])); }
        mhat = rm;
#pragma unroll
        for (int r = 0; r < 16; ++r) { pA0[r] = EX(pA0[r] - rm); pA1[r] = EX(pA1[r] - rm); negm[r] = -mhat; }
        asm volatile("" : "+v"(negm));
    }
    WAIT_BAR(0);
    if (3 < NT) DMA_K(3, 0);
    DMA_V(1, SLOTB);
    ROT();
#pragma unroll
    for (int j = 0; j < 4; ++j) kload2(kf, kp0 + sl_cur, j);
    if (3 < NT) WAIT_BAR(4); else if (2 < NT) WAIT_BAR(2); else WAIT_BAR(0);
    u32x4 pw0, pw1, pw2, pw3;
    s16x4 va0, va1, vb0, vb1, vc0, vc1, vd0, vd1, ve0, ve1, vf0, vf1;
#define PKW(P_, B_) cvtpk(P_[B_], P_[(B_) + 1])
#define VFRAG(lo_, hi_) (bf16x8){lo_[0], lo_[1], lo_[2], lo_[3], hi_[0], hi_[1], hi_[2], hi_[3]}
#define VRD(lo_, hi_, i_) do { lo_ = vtr(vp_ + (((i_) & 3) * 4096 + ((i_) >> 2) * 1024)); hi_ = vtr(vp_ + (((i_) & 3) * 4096 + ((i_) >> 2) * 1024 + 512)); } while (0)
#define GAPA(MF, A0, A1, A2, A3, W0, W1, PW) do { MF; sacc += A0; sacc += A1; sacc += A2; sacc += A3; PIN(sacc); W0; W1; PIN(PW); SBAR(); } while (0)
#define KRD(G, j) do { if (G) { kload2(kf, kp0 + sl_next, j); } } while (0)
#define GAPB(i_, PW_, lo_, hi_, X_, B_, RD) do { RD; o[(i_) & 3] = MFMA(__builtin_bit_cast(bf16x8, PW_), VFRAG(lo_, hi_), o[(i_) & 3]); X_[B_] = EX(X_[B_]); X_[(B_) + 1] = EX(X_[(B_) + 1]); PIN(X_); SBAR(); } while (0)
#define STEP(C0, C1, P0, P1, t, GK, GV, GL) do { SBAR(); \
    const lds_cptr vp_ = vp0 + sl_prev; \
    float sacc = (P0[0] + P0[1]); \
    GAPA(C0 = MFMA(kf[0], qr[0], negm), P0[2], P0[3], P0[4], P0[5],     pw0[0] = PKW(P0, 0),  pw0[1] = PKW(P0, 2),  pw0); \
    GAPA(C1 = MFMA(kf[1], qr[0], negm), P0[6], P0[7], P0[8], P0[9],     pw0[2] = PKW(P0, 4),  pw0[3] = PKW(P0, 6),  pw0); \
    GAPA(C0 = MFMA(kf[2], qr[1], C0),   P0[10], P0[11], P0[12], P0[13], pw1[0] = PKW(P0, 8),  pw1[1] = PKW(P0, 10), pw1); \
    GAPA(C1 = MFMA(kf[3], qr[1], C1),   P0[14], P0[15], P1[0], P1[1],   pw1[2] = PKW(P0, 12), pw1[3] = PKW(P0, 14), pw1); \
    VRD(va0, va1, 0); SBAR(); \
    GAPA(C0 = MFMA(kf[4], qr[2], C0),   P1[2], P1[3], P1[4], P1[5],     pw2[0] = PKW(P1, 0),  pw2[1] = PKW(P1, 2),  pw2); \
    VRD(vb0, vb1, 1); SBAR(); \
    GAPA(C1 = MFMA(kf[5], qr[2], C1),   P1[6], P1[7], P1[8], P1[9],     pw2[2] = PKW(P1, 4),  pw2[3] = PKW(P1, 6),  pw2); \
    VRD(vc0, vc1, 2); SBAR(); \
    GAPA(C0 = MFMA(kf[6], qr[3], C0),   P1[10], P1[11], P1[12], P1[13], pw3[0] = PKW(P1, 8),  pw3[1] = PKW(P1, 10), pw3); \
    VRD(vd0, vd1, 3); SBAR(); \
    GAPA(C1 = MFMA(kf[7], qr[3], C1),   P1[14], P1[15], 0.f, 0.f,       pw3[2] = PKW(P1, 12), pw3[3] = PKW(P1, 14), pw3); \
    l_reg += sacc; \
    if (GK) { DMA_K((t) + 3, sl_cur); } if (GV) { DMA_V((t) + 1, sl_next); } \
    BAND(C0, C1, t); \
    { float a = MX3(C0[0], C0[1], C1[0]), b_ = MX3(C0[2], C0[3], C1[1]); a = MX3(a, C1[2], C1[3]); \
      _Pragma("unroll") for (int r = 4; r < 16; r += 4) { a = MX3(a, C0[r], C0[r + 1]); b_ = MX3(b_, C0[r + 2], C0[r + 3]); a = MX3(a, C1[r], C1[r + 1]); b_ = MX3(b_, C1[r + 2], C1[r + 3]); } \
      float rm = __builtin_fmaxf(a, b_); { auto rr = __builtin_amdgcn_permlane32_swap(__float_as_uint(rm), __float_as_uint(rm), false, false); rm = __builtin_fmaxf(__uint_as_float(rr[0]), __uint_as_float(rr[1])); } \
      resc = false; \
      if (__builtin_expect(__any(rm > (float)THRL), 0)) { const float dl = __builtin_fmaxf(rm, 0.f); mhat += dl; \
        _Pragma("unroll") for (int r = 0; r < 16; ++r) { C0[r] -= dl; C1[r] -= dl; } \
        _Pragma("unroll") for (int r = 0; r < 16; ++r) negm[r] = -mhat; asm volatile("" : "+v"(negm)); \
        const float f = __builtin_amdgcn_exp2f(-dl); l_reg *= f; if (hi == 0) wsf[r32] = f; resc = true; } } \
    SBAR(); \
    GAPB(0, pw0, va0, va1, C0, 0, VRD(ve0, ve1, 4)); \
    GAPB(1, pw0, vb0, vb1, C0, 2, VRD(vf0, vf1, 5)); \
    GAPB(2, pw0, vc0, vc1, C0, 4, VRD(va0, va1, 6); KRD(GL, 0)); \
    GAPB(3, pw0, vd0, vd1, C0, 6, VRD(vb0, vb1, 7)); \
    GAPB(4, pw1, ve0, ve1, C0, 8, VRD(vc0, vc1, 8); KRD(GL, 1)); \
    GAPB(5, pw1, vf0, vf1, C0, 10, VRD(vd0, vd1, 9)); \
    GAPB(6, pw1, va0, va1, C0, 12, VRD(ve0, ve1, 10); KRD(GL, 2)); \
    GAPB(7, pw1, vb0, vb1, C0, 14, VRD(vf0, vf1, 11)); \
    GAPB(8, pw2, vc0, vc1, C1, 0, VRD(va0, va1, 12); KRD(GL, 3)); \
    GAPB(9, pw2, vd0, vd1, C1, 2, VRD(vb0, vb1, 13)); \
    GAPB(10, pw2, ve0, ve1, C1, 4, VRD(vc0, vc1, 14)); \
    GAPB(11, pw2, vf0, vf1, C1, 6, VRD(vd0, vd1, 15)); \
    GAPB(12, pw3, va0, va1, C1, 8, (void)0); \
    GAPB(13, pw3, vb0, vb1, C1, 10, (void)0); \
    GAPB(14, pw3, vc0, vc1, C1, 12, (void)0); \
    GAPB(15, pw3, vd0, vd1, C1, 14, (void)0); \
    } while (0)
#define ENDW(tt) do { if ((tt) + 3 < NT) { WAIT_BAR(4); } else if ((tt) + 2 < NT) { WAIT_BAR(2); } else { WAIT_BAR(0); } } while (0)
    int t = 1;
    for (; t + 5 < NT; t += 2) {
        STEP(pB0, pB1, pA0, pA1, t, true, true, true);         WAIT_BAR(4); RESC(); ROT();
        STEP(pA0, pA1, pB0, pB1, t + 1, true, true, true);     WAIT_BAR(4); RESC(); ROT();
    }
    for (; t + 1 < NT; t += 2) {
        STEP(pB0, pB1, pA0, pA1, t, (t + 3 < NT), (t + 1 < NT), (t + 1 < NT));         ENDW(t);     RESC(); ROT();
        STEP(pA0, pA1, pB0, pB1, t + 1, (t + 4 < NT), (t + 2 < NT), (t + 2 < NT));     ENDW(t + 1); RESC(); ROT();
    }
    STEP(pB0, pB1, pA0, pA1, NT - 1, false, false, false); RESC();
    {
        float sacc = 0.f;
#pragma unroll
        for (int r = 0; r < 16; ++r) sacc += pB0[r] + pB1[r];
        l_reg += sacc;
        pw0 = (u32x4){PKW(pB0, 0), PKW(pB0, 2), PKW(pB0, 4), PKW(pB0, 6)}; pw1 = (u32x4){PKW(pB0, 8), PKW(pB0, 10), PKW(pB0, 12), PKW(pB0, 14)};
        pw2 = (u32x4){PKW(pB1, 0), PKW(pB1, 2), PKW(pB1, 4), PKW(pB1, 6)}; pw3 = (u32x4){PKW(pB1, 8), PKW(pB1, 10), PKW(pB1, 12), PKW(pB1, 14)};
        const lds_cptr vp_ = vp0 + sl_cur;
        s16x4 da0, da1, db0, db1, dc0, dc1, dd0, dd1;
        VRD(da0, da1, 0); VRD(db0, db1, 1); VRD(dc0, dc1, 2); VRD(dd0, dd1, 3); SBAR();
#define DGAP(i_, PW_, lo_, hi_, RD) do { o[(i_) & 3] = MFMA(__builtin_bit_cast(bf16x8, PW_), VFRAG(lo_, hi_), o[(i_) & 3]); RD; SBAR(); } while (0)
        DGAP(0, pw0, da0, da1, VRD(da0, da1, 4));   DGAP(1, pw0, db0, db1, VRD(db0, db1, 5));   DGAP(2, pw0, dc0, dc1, VRD(dc0, dc1, 6));   DGAP(3, pw0, dd0, dd1, VRD(dd0, dd1, 7));
        DGAP(4, pw1, da0, da1, VRD(da0, da1, 8));   DGAP(5, pw1, db0, db1, VRD(db0, db1, 9));   DGAP(6, pw1, dc0, dc1, VRD(dc0, dc1, 10));  DGAP(7, pw1, dd0, dd1, VRD(dd0, dd1, 11));
        DGAP(8, pw2, da0, da1, VRD(da0, da1, 12));  DGAP(9, pw2, db0, db1, VRD(db0, db1, 13));  DGAP(10, pw2, dc0, dc1, VRD(dc0, dc1, 14)); DGAP(11, pw2, dd0, dd1, VRD(dd0, dd1, 15));
        DGAP(12, pw3, da0, da1, (void)0);           DGAP(13, pw3, db0, db1, (void)0);           DGAP(14, pw3, dc0, dc1, (void)0);           DGAP(15, pw3, dd0, dd1, (void)0);
#undef DGAP
    }
    l_reg = half_sum(l_reg);
    if (hi == 0) wsf[32 + r32] = 1.0f / l_reg;
    asm volatile("s_waitcnt lgkmcnt(0)" ::: "memory");
#pragma unroll
    for (int r = 0; r < 16; ++r) { const float il = wsf[32 + crow(r, hi)];
#pragma unroll
        for (int d = 0; d < 4; ++d) o[d][r] *= il; }
    WAIT_BAR(0);
#define LBAR() asm volatile("s_waitcnt lgkmcnt(0)\n\ts_barrier" ::: "memory")
    if (nqb >= 0) {
        const unsigned short* nk = P.kt + (size_t)(nb * NH + nh) * 64 * 8192 + wid * 512 + lane * 8;
        const unsigned short* nv = P.vt + (size_t)(nb * NH + nh) * 64 * 8192 + wid * 512 + lane * 8;
        glds16(nk, (unsigned)__builtin_amdgcn_readfirstlane(kdst)); glds16(nk + 4096, (unsigned)__builtin_amdgcn_readfirstlane(kdst + 8192));
        glds16(nv, (unsigned)__builtin_amdgcn_readfirstlane(vdst)); glds16(nv + 4096, (unsigned)__builtin_amdgcn_readfirstlane(vdst + 8192));
        glds16(nk + 8192, (unsigned)__builtin_amdgcn_readfirstlane(kdst + SLOTB)); glds16(nk + 8192 + 4096, (unsigned)__builtin_amdgcn_readfirstlane(kdst + 8192 + SLOTB));
        if (nqb > 0) { glds16(nk + 2 * 8192, (unsigned)__builtin_amdgcn_readfirstlane(kdst + 2 * SLOTB)); glds16(nk + 2 * 8192 + 4096, (unsigned)__builtin_amdgcn_readfirstlane(kdst + 8192 + 2 * SLOTB)); }
    }
    const lds_fptr cmb = (lds_fptr)(lds + LDS_CMB) + rg * 4096;
    if (map == 1) {
#pragma unroll
        for (int d = 0; d < 4; ++d)
#pragma unroll
            for (int r = 0; r < 16; ++r) cmb[crow(r, hi) * 128 + d * 32 + r32] = o[d][r];
    }
    LBAR();
    if (map == 0) {
        const float lam = P.lam;
        float gsub[4];
#pragma unroll
        for (int d = 0; d < 4; ++d) gsub[d] = P.subln_g[d * 32 + r32];
        f32x16 sq;
#pragma unroll
        for (int r = 0; r < 16; ++r) sq[r] = 0.f;
#pragma unroll
        for (int d = 0; d < 4; ++d) {
            f32x16 c;
#pragma unroll
            for (int r = 0; r < 16; ++r) c[r] = cmb[crow(r, hi) * 128 + d * 32 + r32];
            PIN(c);
#pragma unroll
            for (int r = 0; r < 16; ++r) { const float v = o[d][r] - lam * c[r]; o[d][r] = v; sq[r] += v * v; }
        }
#pragma unroll
        for (int s = 1; s < 32; s <<= 1) {
            f32x16 t;
#pragma unroll
            for (int r = 0; r < 16; ++r) t[r] = __shfl_xor(sq[r], s);
            PIN(t);
#pragma unroll
            for (int r = 0; r < 16; ++r) sq[r] += t[r];
        }
#pragma unroll
        for (int r = 0; r < 16; ++r) sq[r] = __builtin_amdgcn_rsqf(sq[r] * (1.0f / 128.0f) + SUBLN_EPS) * (1.0f - P.lam_init);
        asm volatile("s_waitcnt lgkmcnt(0)" ::: "memory");
        __attribute__((address_space(3))) unsigned short* ot = (__attribute__((address_space(3))) unsigned short*)cmb;
#pragma unroll
        for (int r = 0; r < 16; ++r) {
#pragma unroll
            for (int d = 0; d < 4; ++d) { const float v = o[d][r] * sq[r] * gsub[d]; ot[crow(r, hi) * 128 + d * 32 + r32] = (unsigned short)(cvtpk(v, v) & 0xffffu); }
        }
    }
    LBAR();
    {
#pragma unroll
        for (int i = 0; i < 4; ++i) { const int c = tid + i * 512, row = c >> 4, ch = c & 15;
            const __attribute__((address_space(3))) unsigned short* ot = (const __attribute__((address_space(3))) unsigned short*)(lds + LDS_CMB + (row >> 5) * 16384) + (row & 31) * 128 + ch * 8;
            pg8::st16(P.mix + (rowbase + q0 + row) * DM + h * 128 + ch * 8, *(const __attribute__((address_space(3))) u32x4*)ot); }
    }
    LBAR();
#undef LBAR
#undef DMA_K
#undef DMA_V
#undef BAND
#undef RESC
#undef ROT
#undef PKW
#undef VFRAG
#undef VRD
#undef GAPA
#undef KRD
#undef GAPB
#undef STEP
#undef ENDW
}
#undef SBAR
#undef PIN
#undef WAIT_BAR
#undef MFMA
#undef MX3
#undef EX
}
#define LAS __attribute__((address_space(3)))
typedef unsigned short bf16;
typedef unsigned v4u __attribute__((ext_vector_type(4)));
typedef float f32x4 __attribute__((ext_vector_type(4)));
constexpr int NWAVES = 8;
constexpr int RING_BYTES = 131072, LDS_BYTES = 147456;
constexpr int NPHASE = 12;
constexpr size_t MiB = 1u << 20;
constexpr size_t WS_W = 2 * MiB;
constexpr size_t W_IN = 0, W_O = 5 * MiB, W_GU = 7 * MiB, W_D = 18 * MiB, W_P = 18 * MiB + 5632 * 1024, W_LAYER = 24 * MiB;
constexpr size_t WS_SSQ = 50 * MiB, WS_XB = 52 * MiB, WS_PROJ = 116 * MiB, WS_MIX = 276 * MiB, WS_H = 116 * MiB, WS_KT = 340 * MiB, WS_VT = 372 * MiB, WS_END = 404 * MiB;
static_assert(WS_W + 2 * W_LAYER <= WS_SSQ && WS_SSQ + (size_t)M * 16 * 4 <= WS_XB && WS_XB + (size_t)M * DM * 2 <= WS_PROJ && WS_PROJ + (size_t)M * INC * 2 <= WS_MIX &&
              WS_MIX + (size_t)M * DM * 2 <= WS_KT && WS_H + (size_t)M * DFF * 2 <= WS_KT && WS_KT + (size_t)M * 512 * 2 <= WS_VT && WS_VT + (size_t)M * 512 * 2 <= WS_END, "d_ws map");

__device__ __forceinline__ unsigned f2bf(float f) { unsigned u = __builtin_bit_cast(unsigned, f); return (u + 0x7fffu + ((u >> 16) & 1u)) >> 16; }
__device__ __forceinline__ unsigned pk2(float lo, float hi) { return f2bf(lo) | (f2bf(hi) << 16); }
__device__ __forceinline__ float bf2f(unsigned short v) { return __builtin_bit_cast(float, (unsigned)v << 16); }
__device__ __forceinline__ float wave_sum(float v) {
#pragma unroll
    for (int o = 1; o < 64; o <<= 1) v += __shfl_xor(v, o);
    return v;
}
#define LDS_WAIT() asm volatile("s_waitcnt lgkmcnt(0)" ::: "memory")

#ifndef PREFIX
#define PREFIX 99
#endif
#ifndef COOP_LAUNCH
#define COOP_LAUNCH 0
#endif
#ifndef ONE_LAUNCH
#define ONE_LAUNCH 1
#endif

struct Args { const float* in[18]; float* out; unsigned char* ws; int ph_lo, ph_hi, use_sync, pad; };
typedef const Args __attribute__((address_space(4)))* KArgsP;
__device__ __forceinline__ int s_opaque(int v) { asm volatile("" : "+s"(v)); return v; }
#define GDX() s_opaque((int)gridDim.x)
#define BIX() s_opaque((int)blockIdx.x)
__device__ __forceinline__ KArgsP kargs() { KArgsP p = (KArgsP)__builtin_amdgcn_kernarg_segment_ptr(); asm volatile("" : "+s"(p)); return p; }

__device__ __forceinline__ void transpose_item(const float* W, int K, int N, const float* gk, bf16* WT, int k0, int n0, int out_row0, LAS float* scr, int lane) {
    float v[32];
    const float* wp = W + (size_t)(k0 + (lane >> 5)) * N + n0 + (lane & 31);
#pragma unroll
    for (int i = 0; i < 32; ++i) v[i] = __builtin_nontemporal_load(wp + (size_t)(2 * i) * N);
    if (gk) {
#pragma unroll
        for (int i = 0; i < 32; ++i) v[i] *= gk[k0 + 2 * i + (lane >> 5)];
    }
#pragma unroll
    for (int i = 0; i < 32; ++i) scr[(2 * i + (lane >> 5)) * 33 + (lane & 31)] = v[i];
    LDS_WAIT(); asm volatile("" ::: "memory");
    const int c = lane & 7;
#pragma unroll
    for (int j = 0; j < 4; ++j) { const int n = (lane >> 3) + 8 * j; const LAS float* s = scr + (8 * c) * 33 + n;
        v4u o; o.x = pk2(s[0 * 33], s[1 * 33]); o.y = pk2(s[2 * 33], s[3 * 33]); o.z = pk2(s[4 * 33], s[5 * 33]); o.w = pk2(s[6 * 33], s[7 * 33]);
        pg8::st16(WT + (size_t)(out_row0 + n) * K + k0 + 8 * c, o); }
    LDS_WAIT(); asm volatile("" ::: "memory");
}

__device__ __forceinline__ void phase_prologue(KArgsP ap, unsigned char* ws_, LAS unsigned char* lds, int vcu, int G, int wave, int lane) {
    LAS float* scr = (LAS float*)(lds + wave * 16384);
    const int gw = vcu * NWAVES + wave, NGW = G * NWAVES;
    constexpr int I_IN = (DM / 64) * (INC / 32), I_O = (DM / 64) * (DM / 32), I_G = (DM / 64) * (DFF / 32), I_D = (DFF / 64) * (DM / 32), I_P = 4;
    constexpr int I_LAYER = I_IN + I_O + 2 * I_G + I_D + I_P;
    for (int it = gw; it < DEPTH * I_LAYER; it += NGW) {
        const int l = it / I_LAYER; int r = it % I_LAYER;
        bf16* wl = (bf16*)(ws_ + WS_W + (size_t)l * W_LAYER);
        if (r < I_IN) { const int nb = INC / 32, k0 = 64 * (r / nb), n0 = 32 * (r % nb);
            transpose_item(ap->in[2] + (size_t)l * DM * INC, DM, INC, ap->in[1] + l * DM, (bf16*)((char*)wl + W_IN), k0, n0, n0, scr, lane); continue; } r -= I_IN;
        if (r < I_O) { const int nb = DM / 32, k0 = 64 * (r / nb), n0 = 32 * (r % nb);
            transpose_item(ap->in[12] + (size_t)l * DM * DM, DM, DM, nullptr, (bf16*)((char*)wl + W_O), k0, n0, n0, scr, lane); continue; } r -= I_O;
        if (r < 2 * I_G) { const int up = r >= I_G; if (up) r -= I_G; const int nb = DFF / 32, k0 = 64 * (r / nb), n0 = 32 * (r % nb);
            transpose_item(ap->in[up ? 15 : 14] + (size_t)l * DM * DFF, DM, DFF, ap->in[13] + l * DM, (bf16*)((char*)wl + W_GU), k0, n0, 256 * (n0 / 128) + (n0 % 128) + (up ? 128 : 0), scr, lane); continue; } r -= 2 * I_G;
        if (r < I_D) { const int nb = DM / 32, k0 = 64 * (r / nb), n0 = 32 * (r % nb);
            transpose_item(ap->in[16] + (size_t)l * DFF * DM, DFF, DM, nullptr, (bf16*)((char*)wl + W_D), k0, n0, n0, scr, lane); continue; } r -= I_D;
        {
            const float* wsrc = ap->in[9] + ((size_t)l * 4 + r) * 64 * 64; bf16* wdst = (bf16*)((char*)wl + W_P) + (size_t)r * 64 * 64;
            transpose_item(wsrc, 64, 64, nullptr, wdst, 0, 0, 0, scr, lane); transpose_item(wsrc, 64, 64, nullptr, wdst, 0, 32, 32, scr, lane);
        }
    }
    bf16* XB = (bf16*)(ws_ + WS_XB); float* SSQ = (float*)(ws_ + WS_SSQ);
    for (int m0 = gw * 8; m0 < M; m0 += NGW * 8) {
        f32x4 v[8][4];
#pragma unroll
        for (int q = 0; q < 8; ++q) { const f32x4* xr = (const f32x4*)(ap->in[0] + (size_t)(m0 + q) * DM) + lane;
#pragma unroll
            for (int j = 0; j < 4; ++j) v[q][j] = __builtin_nontemporal_load(xr + 64 * j); }
#pragma unroll
        for (int q = 0; q < 8; ++q) {
            float s = 0.f;
#pragma unroll
            for (int j = 0; j < 4; ++j) s += (v[q][j][0] * v[q][j][0] + v[q][j][1] * v[q][j][1]) + (v[q][j][2] * v[q][j][2] + v[q][j][3] * v[q][j][3]);
            s = wave_sum(s);
            unsigned long long* o8 = (unsigned long long*)(XB + (size_t)(m0 + q) * DM) + lane;
#pragma unroll
            for (int j = 0; j < 4; ++j) o8[64 * j] = (unsigned long long)pk2(v[q][j][0], v[q][j][1]) | ((unsigned long long)pk2(v[q][j][2], v[q][j][3]) << 32);
            if (lane < 4) SSQ[(size_t)(m0 + q) * 4 + lane] = (lane == 0) ? s : 0.f;
        }
    }
}

typedef short pc_bf16x8 __attribute__((ext_vector_type(8)));
typedef float pc_f32x16 __attribute__((ext_vector_type(16)));
template <int W>
__device__ __forceinline__ void pooled_block(const LAS unsigned* Ps32, LAS unsigned* At32, int tb, int g, int cp, int t0) {
    float lo[15 + W], hi[15 + W];
    unsigned raw[15 + W];
#pragma unroll
    for (int i = 0; i < 15 + W; ++i) raw[i] = Ps32[(16 * tb + 16 - W + i) * 128 + 32 * g + cp];
#pragma unroll
    for (int i = 0; i < 15 + W; ++i) asm volatile("" : "+v"(raw[i]));
#pragma unroll
    for (int i = 0; i < 15 + W; ++i) { const unsigned u = raw[i]; lo[i] = __builtin_bit_cast(float, u << 16); hi[i] = __builtin_bit_cast(float, u & 0xffff0000u); }
    float sl = 0.f, sh = 0.f;
#pragma unroll
    for (int i = 0; i < W; ++i) { sl += lo[i]; sh += hi[i]; }
#pragma unroll
    for (int i = 0; i < 16; ++i) {
        const int t = t0 + 16 * tb + i;
        const float inv = 1.0f / (float)((t + 1) < W ? (t + 1) : W);
        const float pl = sl * inv - lo[W - 1 + i], ph = sh * inv - hi[W - 1 + i];
        At32[(16 * tb + i) * 132 + 32 * g + cp] = pk2(pl, ph);
        if (i < 15) { sl += lo[W + i] - lo[i]; sh += hi[W + i] - hi[i]; }
    }
}
__device__ __forceinline__ void poolconv_unit(int u, const bf16* PROJ, bf16* MIX, const bf16* WpT, const float* pool_scale, const float* conv_w, LAS unsigned char* lds) {
    int tid_ = threadIdx.x; asm volatile("" : "+v"(tid_));
    const int tid = tid_, lane = tid & 63, wave = __builtin_amdgcn_readfirstlane(tid >> 6);
    const size_t R0 = (size_t)u * 64; const int t0 = (int)(R0 % SEQ);
    LAS bf16* Ps = (LAS bf16*)lds;
    LAS unsigned char* At = lds + 40960;
    LAS bf16* Ot = (LAS bf16*)(lds + 40960 + 33792);
    pc_bf16x8 bfr[2][4]; float psc[2];
    { const int g = wave & 3, r32 = lane & 31, hi = lane >> 5;
#pragma unroll
      for (int cb = 0; cb < 2; ++cb) { psc[cb] = pool_scale[g * 64 + cb * 32 + r32];
#pragma unroll
          for (int ks = 0; ks < 4; ++ks) bfr[cb][ks] = *(const pc_bf16x8*)(WpT + ((size_t)(g * 64 + cb * 32 + r32)) * 64 + ks * 16 + 8 * hi); } }
    v4u sv[5];
#pragma unroll
    for (int k = 0; k < 5; ++k) { const int c = tid + k * 512, j = c >> 5, ch8 = c & 31; const bool ok = (c < 79 * 32) && (t0 - 15 + j >= 0);
        sv[k] = __builtin_nontemporal_load((const v4u*)(PROJ + (ok ? R0 - 15 + j : R0) * INC + C_P + ch8 * 8)); }
    {
        const int tr = tid >> 5, cg8 = (tid & 31) * 8;
        float w0[8], w1[8], w2[8];
#pragma unroll
        for (int e = 0; e < 8; ++e) { w0[e] = conv_w[cg8 + e]; w1[e] = conv_w[256 + cg8 + e]; w2[e] = conv_w[512 + cg8 + e]; }
        v4u gc[6], hn[6], gb[4];
#pragma unroll
        for (int i = 0; i < 6; ++i) { const int tl = tr * 4 + i - 2; const size_t row = (t0 + tl >= 0) ? R0 + tl : R0;
            gc[i] = __builtin_nontemporal_load((const v4u*)(PROJ + row * INC + C_GC + cg8)); hn[i] = __builtin_nontemporal_load((const v4u*)(PROJ + row * INC + C_HIN + cg8)); }
#pragma unroll
        for (int i = 0; i < 4; ++i) gb[i] = __builtin_nontemporal_load((const v4u*)(PROJ + (R0 + tr * 4 + i) * INC + C_GB + cg8));
#pragma unroll
        for (int k = 0; k < 5; ++k) { const int c = tid + k * 512, j = c >> 5, ch8 = c & 31;
            if (c < 79 * 32) *(LAS v4u*)(Ps + j * 256 + ch8 * 8) = (t0 - 15 + j >= 0) ? sv[k] : (v4u){0u, 0u, 0u, 0u}; }
#pragma unroll
        for (int i = 0; i < 2; ++i) if (t0 + tr * 4 + i - 2 < 0) gc[i] = (v4u){0u, 0u, 0u, 0u};
        float uu[6][8];
#pragma unroll
        for (int i = 0; i < 6; ++i)
#pragma unroll
            for (int e = 0; e < 4; ++e) { uu[i][2 * e] = __builtin_bit_cast(float, gc[i][e] << 16) * __builtin_bit_cast(float, hn[i][e] << 16);
                uu[i][2 * e + 1] = __builtin_bit_cast(float, gc[i][e] & 0xffff0000u) * __builtin_bit_cast(float, hn[i][e] & 0xffff0000u); }
#pragma unroll
        for (int i = 0; i < 4; ++i) {
            v4u o;
#pragma unroll
            for (int e = 0; e < 4; ++e) {
                const float y0 = w0[2 * e] * uu[i][2 * e] + w1[2 * e] * uu[i + 1][2 * e] + w2[2 * e] * uu[i + 2][2 * e];
                const float y1 = w0[2 * e + 1] * uu[i][2 * e + 1] + w1[2 * e + 1] * uu[i + 1][2 * e + 1] + w2[2 * e + 1] * uu[i + 2][2 * e + 1];
                o[e] = pk2(__builtin_bit_cast(float, gb[i][e] << 16) * y0, __builtin_bit_cast(float, gb[i][e] & 0xffff0000u) * y1); }
            pg8::st16(MIX + (R0 + tr * 4 + i) * DM + 768 + cg8, o);
        }
    }
    __syncthreads();
    {
        const int g = wave & 3, tb = (lane >> 5) + 2 * (wave >> 2), cp = lane & 31;
        const LAS unsigned* Ps32 = (const LAS unsigned*)lds; LAS unsigned* At32 = (LAS unsigned*)At;
        if (g == 0) pooled_block<2>(Ps32, At32, tb, 0, cp, t0);
        else if (g == 1) pooled_block<4>(Ps32, At32, tb, 1, cp, t0);
        else if (g == 2) pooled_block<8>(Ps32, At32, tb, 2, cp, t0);
        else pooled_block<16>(Ps32, At32, tb, 3, cp, t0);
    }
    __syncthreads();
    {
        const int g = wave & 3, rb = wave >> 2, r32 = lane & 31, hi = lane >> 5;
        pc_f32x16 acc[2];
#pragma unroll
        for (int cb = 0; cb < 2; ++cb)
#pragma unroll
            for (int r = 0; r < 16; ++r) acc[cb][r] = 0.f;
#pragma unroll
        for (int ks = 0; ks < 4; ++ks) {
            const pc_bf16x8 af = *(const LAS pc_bf16x8*)(At + (32 * rb + r32) * 528 + (g * 64 + ks * 16 + 8 * hi) * 2);
#pragma unroll
            for (int cb = 0; cb < 2; ++cb) {
                acc[cb] = __builtin_amdgcn_mfma_f32_32x32x16_bf16(af, bfr[cb][ks], acc[cb], 0, 0, 0);
            }
        }
#pragma unroll
        for (int cb = 0; cb < 2; ++cb) { const float ps = psc[cb];
#pragma unroll
            for (int r = 0; r < 16; ++r) Ot[(32 * rb + (r & 3) + 8 * (r >> 2) + 4 * hi) * 256 + g * 64 + cb * 32 + r32] = (bf16)f2bf(acc[cb][r] * ps); }
    }
    __syncthreads();
    for (int c = tid; c < 64 * 32; c += 512) { const int row = c >> 5, ch8 = c & 31; pg8::st16(MIX + (R0 + row) * DM + 512 + ch8 * 8, *(const LAS v4u*)(Ot + row * 256 + ch8 * 8)); }
    __syncthreads();
}

typedef __attribute__((address_space(1))) unsigned gu32;
#define RLX_AGENT __ATOMIC_RELAXED, __HIP_MEMORY_SCOPE_AGENT
constexpr size_t WS_CTL = 0, CTL_ZERO_BYTES = 65536;
constexpr int MISC_OFF = RING_BYTES + 320;
#define XB_TMO      128
#define XB_XCNT(j)  (256  + 64 * (j))
#define XB_XSUB(j)  (1280 + 64 * (j))
#define XB_XGEN(j)  (2304 + 64 * (j))
#define XB_TOP      3328
#define XB_TOPGEN   3392
#define XCD_BAR_WORDS 3456
#define XB_SPIN_CAP (1u << 18)

__device__ __forceinline__ unsigned xb_ld(unsigned* p)              { return __hip_atomic_load(p, __ATOMIC_RELAXED, __HIP_MEMORY_SCOPE_AGENT); }
__device__ __forceinline__ unsigned xb_add(unsigned* p, unsigned v) { return __hip_atomic_fetch_add(p, v, __ATOMIC_RELAXED, __HIP_MEMORY_SCOPE_AGENT); }
__device__ __forceinline__ unsigned xb_xcc_id() { return (unsigned)__builtin_amdgcn_s_getreg((3 << 11) | 20) & 0xFu; }
#define XB_SPIN(cond, bar) do { unsigned _sp = 0; while (cond) { __builtin_amdgcn_s_sleep(1); \
    if ((++_sp & 255u) == 0u) { if (xb_ld(&(bar)[XB_TMO])) break; if (_sp > XB_SPIN_CAP) { atomicAdd(&(bar)[XB_TMO], 1u); break; } } } } while (0)

struct XcdBarrier {
    unsigned* bar; unsigned x;
    volatile LAS unsigned* st;
};

__device__ __forceinline__ XcdBarrier xcd_barrier_post(unsigned* bar, volatile LAS unsigned* st) {
    XcdBarrier b; b.bar = bar; b.x = xb_xcc_id(); b.st = st;
    if (threadIdx.x == 0) (void)xb_add(&bar[XB_XCNT(b.x)], 1u);
    return b;
}
__device__ __forceinline__ void xcd_barrier_complete(unsigned* bar, unsigned x, unsigned& nloc, unsigned& nx) {
    const unsigned G = gridDim.x * gridDim.y * gridDim.z;
    unsigned sum, cnt, mine, sp = 0u;
    for (;;) {
        sum = 0u; cnt = 0u; mine = 0u;
#pragma unroll
        for (unsigned j = 0; j < 16; ++j) { const unsigned c = xb_ld(&bar[XB_XCNT(j)]); sum += c; cnt += (c > 0u) ? 1u : 0u; }
        mine = xb_ld(&bar[XB_XCNT(x)]);
        if (sum == G) break;
        __builtin_amdgcn_s_sleep(1);
        if ((++sp & 255u) == 0u) { if (xb_ld(&bar[XB_TMO])) break; if (sp > XB_SPIN_CAP) { atomicAdd(&bar[XB_TMO], 1u); break; } }
    }
    nloc = mine > 0u ? mine : 1u; nx = cnt > 0u ? cnt : 1u;
}

__device__ __forceinline__ void xcd_barrier(const XcdBarrier& b) {
    asm volatile("s_waitcnt vmcnt(0)" ::: "memory");
    __syncthreads();
    if (threadIdx.x == 0) {
        unsigned* bar = b.bar;
        __builtin_amdgcn_s_waitcnt(0);
        unsigned nloc = b.st[0], nx = b.st[1];
        if (nloc == 0u) { xcd_barrier_complete(bar, b.x, nloc, nx); b.st[0] = nloc; b.st[1] = nx; }
        const unsigned old = xb_add(&bar[XB_XSUB(b.x)], 1u);
        const unsigned gen = old / nloc;
        if (old + 1u == (gen + 1u) * nloc) {
            __builtin_amdgcn_fence(__ATOMIC_RELEASE, "agent");
            asm volatile("s_waitcnt vmcnt(0)" ::: "memory");
            const unsigned og = xb_add(&bar[XB_TOP], 1u);
            const unsigned tg = og / nx;
            if (og + 1u == (tg + 1u) * nx) xb_add(&bar[XB_TOPGEN], 1u);
            else XB_SPIN(xb_ld(&bar[XB_TOPGEN]) == tg, bar);
            __builtin_amdgcn_fence(__ATOMIC_ACQUIRE, "agent");
            xb_add(&bar[XB_XGEN(b.x)], 1u);
            asm volatile("s_waitcnt vmcnt(0)" ::: "memory");
        } else {
            XB_SPIN(xb_ld(&bar[XB_XGEN(b.x)]) == gen, bar);
            __builtin_amdgcn_fence(__ATOMIC_ACQUIRE, "agent");
            asm volatile("s_waitcnt vmcnt(0)" ::: "memory");
        }
    }
    __syncthreads();
}

template <int NIT>
__device__ __forceinline__ void build_rtab(LAS float* rtab, const float* ssq, const pg8::StaticOrder& S) {
    int t_ = threadIdx.x; asm volatile("" : "+v"(t_));
    const int lim = ((S.nwg + S.G - 1) / S.G) * 256;
    f32x4 a[NIT];
#pragma unroll
    for (int k = 0; k < NIT; ++k) { const int idx = t_ + k * (NWAVES * 64); pg8::Unit u; u.pm = 0; u.pn = 0; (void)S.next(idx < lim ? idx >> 8 : 0, u);
        a[k] = *(const f32x4*)(ssq + (size_t)(u.pm * 256 + (idx & 255)) * 4); }
#pragma unroll
    for (int k = 0; k < NIT; ++k) { const int idx = t_ + k * (NWAVES * 64); pg8::Unit u;
        if (idx < lim && S.next(idx >> 8, u)) rtab[idx] = 1.0f / sqrtf(((a[k][0] + a[k][1]) + (a[k][2] + a[k][3])) * (1.0f / 1024.0f) + 1e-6f); }
    for (int idx = t_ + NIT * (NWAVES * 64); idx < lim; idx += NWAVES * 64) { pg8::Unit u; if (S.next(idx >> 8, u)) rtab[idx] = pg8::row_rstd(ssq, u.pm * 256 + (idx & 255)); }
    __syncthreads();
}
__device__ __forceinline__ int vcu_of(int g, int b) { return (g % 8 == 0) ? (b % 8) * (g / 8) + b / 8 : b; }
__global__ void __launch_bounds__(NWAVES * 64, 2) mega_fwd(Args args) {
    extern __shared__ __attribute__((aligned(16))) unsigned char lds_raw[];
    LAS unsigned char* lds = (LAS unsigned char*)lds_raw;
    const int lo = args.ph_lo, hi = args.ph_hi;
    { int t_ = threadIdx.x; asm volatile("" : "+v"(t_)); for (int u = t_; u < (LDS_BYTES - RING_BYTES) / 4; u += NWAVES * 64) ((LAS unsigned*)(lds + RING_BYTES))[u] = 0u; }
    __syncthreads();
    XcdBarrier bar; bar.bar = (unsigned*)(args.ws + WS_CTL); bar.x = 0; bar.st = nullptr;
    if (args.use_sync & 1) bar = xcd_barrier_post((unsigned*)(args.ws + WS_CTL), (volatile LAS unsigned*)(lds + MISC_OFF) + 8);
    const bool fuse_final = (gridDim.x == 256u) && (lo <= NPHASE - 2) && (hi == NPHASE);
#define IN(k) (lo <= (k) && (k) < hi)
#ifndef EN_MASK
#define EN_MASK 0x1ff
#endif
#define EN(b) ((EN_MASK >> (b)) & 1)
#ifndef BARX
#define BARX 1
#endif
#define SEAM(k) do { if (IN(k) && IN((k) + 1)) { if (args.use_sync & 1) { _Pragma("unroll 1") for (int bx_ = 0; bx_ < BARX; ++bx_) xcd_barrier(bar); } } } while (0)
#define VCU() vcu_of(GDX(), BIX())
    if (EN(0) && IN(0)) {
        int t_ = threadIdx.x; asm volatile("" : "+v"(t_));
        phase_prologue(kargs(), args.ws, lds, VCU(), GDX(), __builtin_amdgcn_readfirstlane(t_ >> 6), t_ & 63);
    }
    SEAM(0);
#pragma unroll 1
    for (int l = 0; l < DEPTH; ++l) {
        const int p0 = 1 + 5 * l;
        if (EN(1) && IN(p0)) {
            unsigned char* ws = args.ws;
            pg8::Gemm g{(const bf16*)(ws + WS_XB), (const bf16*)(ws + WS_W + (size_t)l * W_LAYER + W_IN), M, INC, DM}; pg8::StaticOrder S; S.init(M, INC, GDX(), BIX());
            LAS float* rtab = (LAS float*)(lds + RING_BYTES + 1024);
            build_rtab<(INC / 256 * (M / 256) / 256 + 1) / 2>(rtab, (const float*)(ws + WS_SSQ), S);
            pg8::EpiProj E{(bf16*)(ws + WS_PROJ), (bf16*)(ws + WS_KT), (bf16*)(ws + WS_VT), rtab, INC, QSCALE, args.use_sync & (8 | 16 | 32)};
            pg8::gemm_phase<pg8::EpiProj, pg8::StaticOrder, PG8_ALIGN, PG8_SP2>(lds, g, S, E);
        }
        SEAM(p0);
        if (EN(2) && IN(p0 + 1)) {
            unsigned char* ws = args.ws;
            int t_ = threadIdx.x; asm volatile("" : "+v"(t_));
            const int lane = t_ & 63, vcu = VCU(), G = GDX();
            att3::Params P; P.proj = (const bf16*)(ws + WS_PROJ); P.kt = (const bf16*)(ws + WS_KT); P.vt = (const bf16*)(ws + WS_VT); P.mix = (bf16*)(ws + WS_MIX); P.rel_bias = kargs()->in[8]; P.subln_g = kargs()->in[7] + l * 128;
            P.lam_init = 0.8f - 0.6f * __expf(-0.3f * (float)l);
            { const float a1 = wave_sum(kargs()->in[3][l * 64 + lane] * kargs()->in[4][l * 64 + lane]), a2 = wave_sum(kargs()->in[5][l * 64 + lane] * kargs()->in[6][l * 64 + lane]);
              P.lam = __expf(a1) - __expf(a2) + P.lam_init; }
#pragma unroll 1
            for (int pass = 0; pass < 2; ++pass) {
            if (((pass + vcu) & 1) == 0) {
            if (EN(7) && !(args.use_sync & 2)) {
                const int nun = (G == 256) ? 4 : (BATCH * NH * 32 - vcu + G - 1) / G;
#pragma unroll 1
                for (int i = 0; i < nun; ++i) {
                    int bh, qb, nbh = 0, nqb = -1;
                    if (G == 256) { const int s = vcu & 7; bh = vcu >> 3; qb = (i == 0) ? s : (i == 1) ? 15 - s : (i == 2) ? 16 + s : 31 - s;
                        if (i + 1 < nun) { nbh = bh; nqb = (i == 0) ? 15 - s : (i == 1) ? 16 + s : 31 - s; } }
                    else { const int un = vcu + i * G; bh = un >> 5; qb = un & 31; if (i + 1 < nun) { nbh = (un + G) >> 5; nqb = (un + G) & 31; } }
                    att3::attn_unit<8>(bh >> 2, bh & 3, qb, i > 0, nbh >> 2, nbh & 3, nqb, P, (att3::lds_ptr)lds);
                }
            }
            } else {
#pragma unroll 1
            for (int un = vcu; EN(8) && !(args.use_sync & 4) && un < M / 64; un += G) poolconv_unit(un, (const bf16*)(ws + WS_PROJ), (bf16*)(ws + WS_MIX), (const bf16*)(ws + WS_W + (size_t)l * W_LAYER + W_P), kargs()->in[10] + l * 256, kargs()->in[11] + l * 768, lds);
            } }
        }
        SEAM(p0 + 1);
        if (EN(3) && IN(p0 + 2)) {
            unsigned char* ws = args.ws;
            pg8::Gemm g{(const bf16*)(ws + WS_MIX), (const bf16*)(ws + WS_W + (size_t)l * W_LAYER + W_O), M, DM, DM}; pg8::StaticOrder S; S.init(M, DM, GDX(), BIX());
            pg8::EpiRes E{(bf16*)(ws + WS_XB), (float*)(ws + WS_SSQ), (LAS float*)(lds + RING_BYTES + 4096)};
            pg8::gemm_phase<pg8::EpiRes, pg8::StaticOrder, PG8_ALIGN, PG8_SP2>(lds, g, S, E);
        }
        SEAM(p0 + 2);
        if (EN(4) && IN(p0 + 3)) {
            unsigned char* ws = args.ws;
            pg8::Gemm g{(const bf16*)(ws + WS_XB), (const bf16*)(ws + WS_W + (size_t)l * W_LAYER + W_GU), M, NGU, DM}; pg8::StaticOrder S; S.init(M, NGU, GDX(), BIX());
            LAS float* rtab = (LAS float*)(lds + RING_BYTES + 1024);
            build_rtab<(NGU / 256 * (M / 256) / 256 + 1) / 2>(rtab, (const float*)(ws + WS_SSQ), S);
            pg8::EpiSwiGLU E{(bf16*)(ws + WS_H), rtab, DFF, args.use_sync & 8};
            pg8::gemm_phase<pg8::EpiSwiGLU, pg8::StaticOrder, PG8_ALIGN, PG8_SP2>(lds, g, S, E);
        }
        SEAM(p0 + 3);
        if (EN(5) && IN(p0 + 4)) {
            unsigned char* ws = args.ws;
            pg8::Gemm g{(const bf16*)(ws + WS_H), (const bf16*)(ws + WS_W + (size_t)l * W_LAYER + W_D), M, DM, DFF}; pg8::StaticOrder S; S.init(M, DM, GDX(), BIX());
            if (l == DEPTH - 1 && fuse_final) {
                pg8::EpiResFinal E{(const bf16*)(ws + WS_XB), (float*)(ws + WS_SSQ), kargs()->out, kargs()->in[17], (unsigned*)(ws + 32768), (LAS float*)(lds + RING_BYTES + 4096)};
                pg8::gemm_phase<pg8::EpiResFinal, pg8::StaticOrder, PG8_ALIGN, PG8_SP2>(lds, g, S, E);
            } else {
                pg8::EpiRes E{(bf16*)(ws + WS_XB), (float*)(ws + WS_SSQ), (LAS float*)(lds + RING_BYTES + 4096)};
                pg8::gemm_phase<pg8::EpiRes, pg8::StaticOrder, PG8_ALIGN, PG8_SP2>(lds, g, S, E);
            }
        }
        if (!(l == DEPTH - 1 && fuse_final)) SEAM(p0 + 4);
    }
    if (EN(6) && IN(NPHASE - 1) && !fuse_final) {
        int t_ = threadIdx.x; asm volatile("" : "+v"(t_));
        const int lane = t_ & 63, wave = __builtin_amdgcn_readfirstlane(t_ >> 6);
        const int gw = VCU() * NWAVES + wave, NGW = GDX() * NWAVES;
        const bf16* XBf = (const bf16*)(args.ws + WS_XB);
        typedef unsigned u32x2_t __attribute__((ext_vector_type(2)));
        f32x4 gf[4];
#pragma unroll
        for (int j = 0; j < 4; ++j) gf[j] = ((const f32x4*)kargs()->in[17])[lane + 64 * j];
        for (int m0 = gw * 8; m0 < M; m0 += NGW * 8) {
            u32x2_t raw[8][4];
#pragma unroll
            for (int q = 0; q < 8; ++q)
#pragma unroll
                for (int j = 0; j < 4; ++j) raw[q][j] = ((const u32x2_t*)(XBf + (size_t)(m0 + q) * DM))[lane + 64 * j];
#pragma unroll
            for (int q = 0; q < 8; ++q) {
                f32x4 v[4]; float s = 0.f;
#pragma unroll
                for (int j = 0; j < 4; ++j) { v[j][0] = __builtin_bit_cast(float, raw[q][j].x << 16); v[j][1] = __builtin_bit_cast(float, raw[q][j].x & 0xffff0000u);
                    v[j][2] = __builtin_bit_cast(float, raw[q][j].y << 16); v[j][3] = __builtin_bit_cast(float, raw[q][j].y & 0xffff0000u);
                    s += (v[j][0] * v[j][0] + v[j][1] * v[j][1]) + (v[j][2] * v[j][2] + v[j][3] * v[j][3]); }
                s = wave_sum(s);
                const float r = 1.0f / sqrtf(s * (1.0f / DM) + RMS_EPS);
                f32x4* orow = (f32x4*)(kargs()->out + (size_t)(m0 + q) * DM) + lane;
#pragma unroll
                for (int j = 0; j < 4; ++j) __builtin_nontemporal_store(v[j] * r * gf[j], orow + 64 * j);
            }
        }
    }
#undef IN
#undef SEAM
#undef VCU
}

#if PREFIX != 99
namespace ref {
typedef float f32x16 __attribute__((ext_vector_type(16)));
template <class T> __device__ __forceinline__ float ldf(const T* p, size_t i);
template <> __device__ __forceinline__ float ldf<float>(const float* p, size_t i) { return p[i]; }
template <> __device__ __forceinline__ float ldf<unsigned short>(const unsigned short* p, size_t i) { return bf2f(p[i]); }
__global__ void __launch_bounds__(256) k_rmsnorm(const float* x, const float* g, float* out, float eps) {
    const int wave = (blockIdx.x * 256 + threadIdx.x) >> 6, lane = threadIdx.x & 63;
    if (wave >= M) return;
    const float4* xr = (const float4*)(x + (size_t)wave * DM);
    const float4* gr = (const float4*)g;
    float4 v[4]; float s = 0.f;
#pragma unroll
    for (int j = 0; j < 4; ++j) { v[j] = xr[lane + 64 * j]; s += v[j].x * v[j].x + v[j].y * v[j].y + v[j].z * v[j].z + v[j].w * v[j].w; }
    s = wave_sum(s);
    const float r = 1.0f / sqrtf(s * (1.0f / DM) + eps);
    float4* orow = (float4*)(out + (size_t)wave * DM);
#pragma unroll
    for (int j = 0; j < 4; ++j) { const float4 gg = gr[lane + 64 * j]; float4 o; o.x = v[j].x * r * gg.x; o.y = v[j].y * r * gg.y; o.z = v[j].z * r * gg.z; o.w = v[j].w * r * gg.w; orow[lane + 64 * j] = o; }
}
template <int MODE, class TA>
__global__ void __launch_bounds__(256) k_gemm32(const TA* __restrict__ A, int lda, const float* __restrict__ W0, const float* __restrict__ W1, int ldw, float* C, int ldc, int K) {
    const int wave = threadIdx.x >> 6, lane = threadIdx.x & 63, r = lane & 31, h = lane >> 5;
    const int m0 = blockIdx.y * 128 + wave * 32;
    const int n0 = blockIdx.x * (MODE == 2 ? 32 : 64);
    f32x16 acc0, acc1;
#pragma unroll
    for (int i = 0; i < 16; ++i) { acc0[i] = 0.f; acc1[i] = 0.f; }
    const TA* ap = A + (size_t)(m0 + r) * lda + 8 * h;
    const float* b0p = W0 + (size_t)(8 * h) * ldw + n0 + r;
    const float* b1p = (MODE == 2) ? (W1 + (size_t)(8 * h) * ldw + n0 + r) : (W0 + (size_t)(8 * h) * ldw + n0 + 32 + r);
    for (int kb = 0; kb < K; kb += 16) {
        float av[8], bb0[8], bb1[8];
#pragma unroll
        for (int s = 0; s < 8; ++s) { av[s] = ldf<TA>(ap, kb + s); bb0[s] = b0p[(size_t)(kb + s) * ldw]; bb1[s] = b1p[(size_t)(kb + s) * ldw]; }
#pragma unroll
        for (int s = 0; s < 8; ++s) { acc0 = __builtin_amdgcn_mfma_f32_32x32x2f32(av[s], bb0[s], acc0, 0, 0, 0); acc1 = __builtin_amdgcn_mfma_f32_32x32x2f32(av[s], bb1[s], acc1, 0, 0, 0); }
    }
#pragma unroll
    for (int reg = 0; reg < 16; ++reg) {
        const int row = m0 + (reg & 3) + 8 * (reg >> 2) + 4 * h;
        float* cp = C + (size_t)row * ldc + n0 + r;
        if (MODE == 0) { cp[0] = acc0[reg]; cp[32] = acc1[reg]; }
        else if (MODE == 1) { cp[0] += acc0[reg]; cp[32] += acc1[reg]; }
        else { const float g = acc0[reg]; cp[0] = g / (1.0f + __expf(-g)) * acc1[reg]; }
    }
}
template <class T>
__global__ void __launch_bounds__(512) k_attn_naive(const T* __restrict__ proj, float qmul, const float* __restrict__ rel_bias,
                                                    const float* __restrict__ lq1, const float* __restrict__ lk1, const float* __restrict__ lq2, const float* __restrict__ lk2,
                                                    const float* __restrict__ subln_g, float lam_init, float* __restrict__ mixed) {
    __shared__ float sm[8192];
    __shared__ float ss[4][64];
    __shared__ float lam_s;
    float* Ks = sm; float* Vs = sm + 4096;
    const int tid = threadIdx.x, map = tid >> 8, quarter = (tid >> 6) & 3, ql = tid & 63;
    const int qb = blockIdx.x, h = blockIdx.y, b = blockIdx.z;
    const size_t rowbase = (size_t)b * SEQ;
    const int t = qb * 64 + ql;
    if (tid == 0) {
        float s1 = 0.f, s2 = 0.f;
        for (int i = 0; i < 64; ++i) { s1 += lq1[i] * lk1[i]; s2 += lq2[i] * lk2[i]; }
        lam_s = expf(s1) - expf(s2) + lam_init;
    }
    float q[64];
#pragma unroll
    for (int i = 0; i < 64; ++i) q[i] = ldf<T>(proj, (rowbase + t) * INC + C_Q + h * 128 + map * 64 + i) * qmul;
    float o[32];
#pragma unroll
    for (int i = 0; i < 32; ++i) o[i] = 0.f;
    float mrun = -1e30f, lrun = 0.f;
    const int nchunk = (qb * 64 + 64) / 32;
    for (int kc = 0; kc < nchunk; ++kc) {
        __syncthreads();
        for (int i = tid; i < 4096; i += 512) { const int mp = i >> 11, key = (i >> 6) & 31, c = i & 63; Ks[i] = ldf<T>(proj, (rowbase + kc * 32 + key) * INC + C_K + h * 128 + mp * 64 + c); }
        for (int i = tid; i < 4096; i += 512) { const int key = i >> 7, c = i & 127; Vs[i] = ldf<T>(proj, (rowbase + kc * 32 + key) * INC + C_V + h * 128 + c); }
        __syncthreads();
#pragma unroll 1
        for (int j = 0; j < 32; ++j) {
            const int key = kc * 32 + j, dist = t - key;
            if (dist < 0) continue;
            const float4* kp = (const float4*)(Ks + map * 2048 + j * 64);
            float a = 0.f;
#pragma unroll
            for (int i = 0; i < 16; ++i) { const float4 kv = kp[i]; a += q[4 * i] * kv.x + q[4 * i + 1] * kv.y + q[4 * i + 2] * kv.z + q[4 * i + 3] * kv.w; }
            const float sc = a * 0.125f + rel_bias[rel_bucket(dist) * NH + h];
            const float mnew = fmaxf(mrun, sc);
            const float alpha = __expf(mrun - mnew), p = __expf(sc - mnew);
            lrun = lrun * alpha + p;
            const float4* vp = (const float4*)(Vs + j * 128 + quarter * 32);
#pragma unroll
            for (int i = 0; i < 8; ++i) { const float4 vv = vp[i]; o[4 * i] = o[4 * i] * alpha + p * vv.x; o[4 * i + 1] = o[4 * i + 1] * alpha + p * vv.y; o[4 * i + 2] = o[4 * i + 2] * alpha + p * vv.z; o[4 * i + 3] = o[4 * i + 3] * alpha + p * vv.w; }
            mrun = mnew;
        }
    }
    const float inv = 1.0f / lrun;
#pragma unroll
    for (int i = 0; i < 32; ++i) o[i] *= inv;
    __syncthreads();
    float* Cs = sm;
    if (map == 1) {
#pragma unroll
        for (int i = 0; i < 32; ++i) Cs[ql * 128 + quarter * 32 + i] = o[i];
    }
    __syncthreads();
    if (map == 0) {
        const float lam = lam_s; float sq = 0.f;
#pragma unroll
        for (int i = 0; i < 32; ++i) { o[i] -= lam * Cs[ql * 128 + quarter * 32 + i]; sq += o[i] * o[i]; }
        ss[quarter][ql] = sq;
    }
    __syncthreads();
    if (map == 0) {
        const float tot = ss[0][ql] + ss[1][ql] + ss[2][ql] + ss[3][ql];
        const float rn = 1.0f / sqrtf(tot * (1.0f / 128.0f) + 1e-5f) * (1.0f - lam_init);
        float* op = mixed + (rowbase + t) * DM + h * 128 + quarter * 32;
#pragma unroll
        for (int i = 0; i < 32; ++i) op[i] = o[i] * rn * subln_g[quarter * 32 + i];
    }
}
template <class T>
__global__ void __launch_bounds__(256) k_pooled(const T* __restrict__ proj, float* __restrict__ pooled) {
    const size_t idx = (size_t)blockIdx.x * 256 + threadIdx.x;
    const int ch = (int)(idx & 255); const size_t row = idx >> 8;
    const int t = (int)(row % SEQ), g = ch >> 6, w = 2 << g;
    float s = 0.f;
    for (int i = 0; i < w; ++i) if (t - i >= 0) s += ldf<T>(proj, (row - i) * INC + C_P + ch);
    const float denom = (float)((t + 1) < w ? (t + 1) : w);
    pooled[row * 256 + ch] = s / denom - ldf<T>(proj, row * INC + C_P + ch);
}
__global__ void __launch_bounds__(256) k_poolmix(const float* __restrict__ pooled, const float* __restrict__ w_pool, const float* __restrict__ pool_scale, float* __restrict__ mixed) {
    const size_t idx = (size_t)blockIdx.x * 256 + threadIdx.x;
    const int ch = (int)(idx & 255); const size_t row = idx >> 8;
    const int g = ch >> 6, d = ch & 63;
    float a = 0.f;
    for (int c = 0; c < 64; ++c) a += pooled[row * 256 + g * 64 + c] * w_pool[(g * 64 + c) * 64 + d];
    mixed[row * DM + 512 + ch] = a * pool_scale[ch];
}
template <class T>
__global__ void __launch_bounds__(256) k_conv(const T* __restrict__ proj, const float* __restrict__ conv_w, float* __restrict__ mixed) {
    const size_t idx = (size_t)blockIdx.x * 256 + threadIdx.x;
    const int ch = (int)(idx & 255); const size_t row = idx >> 8;
    const int t = (int)(row % SEQ);
    float y = 0.f;
#pragma unroll
    for (int k = 0; k < 3; ++k) { const int back = 2 - k; if (t - back >= 0) { const size_t r2 = row - back; y += conv_w[k * 256 + ch] * (ldf<T>(proj, r2 * INC + C_GC + ch) * ldf<T>(proj, r2 * INC + C_HIN + ch)); } }
    mixed[row * DM + 768 + ch] = ldf<T>(proj, row * INC + C_GB + ch) * y;
}
}
#endif

extern "C" void kernel_launch(void* const* d_in, const int* in_sizes, int n_in, void* d_out, int out_size, void* d_ws, size_t ws_size, hipStream_t stream) {
    static int grid = 0;
    if (grid == 0) {
        int dev = 0, cus = 0, per_cu = 0;
        if (hipGetDevice(&dev) != hipSuccess || hipDeviceGetAttribute(&cus, hipDeviceAttributeMultiprocessorCount, dev) != hipSuccess) { fprintf(stderr, "kernel_launch: device query failed\n"); grid = -1; return; }
        if (hipFuncSetAttribute((const void*)mega_fwd, hipFuncAttributeMaxDynamicSharedMemorySize, LDS_BYTES) != hipSuccess) { fprintf(stderr, "kernel_launch: hipFuncSetAttribute failed\n"); grid = -1; return; }
        if (hipOccupancyMaxActiveBlocksPerMultiprocessor(&per_cu, (const void*)mega_fwd, NWAVES * 64, LDS_BYTES) != hipSuccess || per_cu < 1) { fprintf(stderr, "kernel_launch: occupancy query says %d blocks per CU\n", per_cu); per_cu = 1; }
        (void)hipGetLastError();
        grid = cus * (per_cu < 1 ? 1 : 1);
        if (ws_size < WS_END) { fprintf(stderr, "kernel_launch: workspace too small\n"); grid = -1; return; }
    }
    if (grid < 0) return;
    Args a{};
    for (int i = 0; i < 18; ++i) a.in[i] = (const float*)d_in[i];
    a.out = (float*)d_out; a.ws = (unsigned char*)d_ws;
#if PREFIX == 99
#if ONE_LAUNCH
    a.ph_lo = 0; a.ph_hi = NPHASE; a.use_sync = 1;
    if (hipMemsetAsync((char*)d_ws + WS_CTL, 0, CTL_ZERO_BYTES, stream) != hipSuccess) { fprintf(stderr, "kernel_launch: memset of the barrier words failed\n"); return; }
#if COOP_LAUNCH
    void* kargs[] = {&a};
    hipError_t e = hipLaunchCooperativeKernel((const void*)mega_fwd, dim3(grid), dim3(NWAVES * 64), kargs, LDS_BYTES, stream);
    if (e != hipSuccess) fprintf(stderr, "cooperative launch failed: %s (grid %d)\n", hipGetErrorString(e), grid);
#else
    hipLaunchKernelGGL(mega_fwd, dim3(grid), dim3(NWAVES * 64), LDS_BYTES, stream, a);
#endif
#else
#ifndef DUPMASK
#define DUPMASK 0
#endif
#ifndef DUPFLAGS
#define DUPFLAGS 0
#endif
    for (int ph = 0; ph < NPHASE; ++ph) { a.ph_lo = ph; a.ph_hi = ph + 1; a.use_sync = 0; hipLaunchKernelGGL(mega_fwd, dim3(grid), dim3(NWAVES * 64), LDS_BYTES, stream, a);
        if ((DUPMASK >> ph) & 1) { a.use_sync = DUPFLAGS; hipLaunchKernelGGL(mega_fwd, dim3(grid), dim3(NWAVES * 64), LDS_BYTES, stream, a); } }
#endif
#else
    const float* x = (const float*)d_in[0]; const float* g_mix = (const float*)d_in[1]; const float* w_in = (const float*)d_in[2];
    const float* lq1 = (const float*)d_in[3]; const float* lk1 = (const float*)d_in[4]; const float* lq2 = (const float*)d_in[5]; const float* lk2 = (const float*)d_in[6];
    const float* subln_g = (const float*)d_in[7]; const float* rel_bias = (const float*)d_in[8]; const float* w_pool = (const float*)d_in[9]; const float* pool_scale = (const float*)d_in[10];
    const float* conv_w = (const float*)d_in[11]; const float* w_o = (const float*)d_in[12]; const float* g_ffn = (const float*)d_in[13]; const float* w_gate = (const float*)d_in[14];
    const float* w_up = (const float*)d_in[15]; const float* w_down = (const float*)d_in[16]; const float* g_final = (const float*)d_in[17];
    float* X = (float*)d_out; char* ws = (char*)d_ws;
    if (ws_size < 500 * MiB) { fprintf(stderr, "workspace too small for the test build\n"); return; }
    float* R1 = (float*)ws; float* R0 = (float*)(ws + 340 * MiB); float* PL = (float*)(ws + 468 * MiB);
    const unsigned short* PROJb = (const unsigned short*)(ws + WS_PROJ); const unsigned short* MIXb = (const unsigned short*)(ws + WS_MIX); const unsigned short* HBb = (const unsigned short*)(ws + WS_H);
    for (int ph = 0; ph <= PREFIX; ++ph) { a.ph_lo = ph; a.ph_hi = ph + 1; a.use_sync = 0; hipLaunchKernelGGL(mega_fwd, dim3(grid), dim3(NWAVES * 64), LDS_BYTES, stream, a); }
    if (PREFIX < 3) (void)hipMemcpyAsync(X, x, (size_t)M * DM * 4, hipMemcpyDeviceToDevice, stream);
    for (int l = 0; l < DEPTH; ++l) {
        const float lam_init = 0.8f - 0.6f * expf(-0.3f * (float)l);
        const int done = (l == 0) ? PREFIX : 0;
        if (done < 1) {
            ref::k_rmsnorm<<<M / 4, 256, 0, stream>>>(X, g_mix + l * DM, R0, 1e-6f);
            ref::k_gemm32<0, float><<<dim3(INC / 64, M / 128), 256, 0, stream>>>(R0, DM, w_in + (size_t)l * DM * INC, nullptr, INC, R1, INC, DM);
        }
        if (done < 2) {
            if (done == 1) {
                ref::k_attn_naive<unsigned short><<<dim3(SEQ / 64, NH, BATCH), 512, 0, stream>>>(PROJb, 1.0f / QSCALE, rel_bias, lq1 + l * 64, lk1 + l * 64, lq2 + l * 64, lk2 + l * 64, subln_g + l * 128, lam_init, R0);
                ref::k_pooled<unsigned short><<<M, 256, 0, stream>>>(PROJb, PL);
                ref::k_conv<unsigned short><<<M, 256, 0, stream>>>(PROJb, conv_w + l * 3 * 256, R0);
            } else {
                ref::k_attn_naive<float><<<dim3(SEQ / 64, NH, BATCH), 512, 0, stream>>>(R1, 1.0f, rel_bias, lq1 + l * 64, lk1 + l * 64, lq2 + l * 64, lk2 + l * 64, subln_g + l * 128, lam_init, R0);
                ref::k_pooled<float><<<M, 256, 0, stream>>>(R1, PL);
                ref::k_conv<float><<<M, 256, 0, stream>>>(R1, conv_w + l * 3 * 256, R0);
            }
            ref::k_poolmix<<<M, 256, 0, stream>>>(PL, w_pool + (size_t)l * 4 * 64 * 64, pool_scale + l * 256, R0);
        }
        if (done < 3) {
            if (done == 2) ref::k_gemm32<1, unsigned short><<<dim3(DM / 64, M / 128), 256, 0, stream>>>(MIXb, DM, w_o + (size_t)l * DM * DM, nullptr, DM, X, DM, DM);
            else ref::k_gemm32<1, float><<<dim3(DM / 64, M / 128), 256, 0, stream>>>(R0, DM, w_o + (size_t)l * DM * DM, nullptr, DM, X, DM, DM);
        }
        if (done < 4) {
            ref::k_rmsnorm<<<M / 4, 256, 0, stream>>>(X, g_ffn + l * DM, R0, 1e-6f);
            for (int half = 0; half < 2; ++half) {
                const size_t r0 = (size_t)half * (M / 2);
                ref::k_gemm32<2, float><<<dim3(DFF / 32, M / 2 / 128), 256, 0, stream>>>(R0 + r0 * DM, DM, w_gate + (size_t)l * DM * DFF, w_up + (size_t)l * DM * DFF, DFF, R1, DFF, DM);
                ref::k_gemm32<1, float><<<dim3(DM / 64, M / 2 / 128), 256, 0, stream>>>(R1, DFF, w_down + (size_t)l * DFF * DM, nullptr, DM, X + r0 * DM, DM, DFF);
            }
        } else if (done < 5) {
            ref::k_gemm32<1, unsigned short><<<dim3(DM / 64, M / 128), 256, 0, stream>>>(HBb, DFF, w_down + (size_t)l * DFF * DM, nullptr, DM, X, DM, DFF);
        }
    }
    ref::k_rmsnorm<<<M / 4, 256, 0, stream>>>(X, g_final, X, 1e-6f);
#endif
}
```
